# Optimizing an MI355X kernel written in HIP

```python
import math
import jax, jax.numpy as jnp
from jax import lax
import numpy as np

D_MODEL = 2048
BATCH = 4
SEQ = 2048
DEPTH = 1
DEC_BATCH = 128
DEC_SEQ = 1
PAST_LEN = 16384
PAGE_SIZE = 128

D_LRU = D_MODEL
H_LRU = 8
LRU_BW = D_LRU // H_LRU
LRU_C = 8.0
CONV_W = 4
D_S5 = D_MODEL // 2
S5_H = 16
S5_G = D_S5 // S5_H
S5_P = 64
D_FF = ((8 * D_MODEL // 3 + 255) // 256) * 256
IN_WIDTH = D_LRU + D_S5 + 2 * D_MODEL
EPS = 1e-6

kernel_name = "hybrid_rglru_s5_gated_merge_decoder_step"


def rmsnorm(x, g):
    xf = x.astype(jnp.float32)
    y = xf * lax.rsqrt(jnp.mean(xf * xf, axis=-1, keepdims=True) + EPS)
    return (y * g.astype(jnp.float32)).astype(x.dtype)


def causal_dwconv(x, buf, w, b):
    L = x.shape[1]
    xx = jnp.concatenate([buf.astype(x.dtype), x], axis=1)
    y = b + xx[:, 0:L] * w[0]
    for k in range(1, CONV_W):
        y = y + xx[:, k:k + L] * w[k]
    return y.astype(x.dtype), xx[:, L:]


def rg_lru(x, h0, pos, wa, ba, wx, bx, lam):
    Bsz, L, _ = x.shape
    xf = x.astype(jnp.float32)
    xh = xf.reshape(Bsz, L, H_LRU, LRU_BW)
    r = jax.nn.sigmoid(jnp.einsum('blhi,hij->blhj', xh, wa.astype(jnp.float32)) + ba.astype(jnp.float32))
    i = jax.nn.sigmoid(jnp.einsum('blhi,hij->blhj', xh, wx.astype(jnp.float32)) + bx.astype(jnp.float32))
    r = r.reshape(Bsz, L, D_LRU)
    i = i.reshape(Bsz, L, D_LRU)
    log_a = -LRU_C * r * jax.nn.softplus(-lam.astype(jnp.float32))
    a = jnp.exp(log_a)
    mult = jnp.where((pos == 0)[None, :, None], 1.0, jnp.sqrt(-jnp.expm1(2.0 * log_a)))
    bt = mult * (i * xf)

    def step(h, ab):
        a_t, b_t = ab
        h = a_t * h + b_t
        return h, h

    hT, hs = lax.scan(step, h0.astype(jnp.float32), (jnp.swapaxes(a, 0, 1), jnp.swapaxes(bt, 0, 1)))
    return jnp.swapaxes(hs, 0, 1).astype(x.dtype), hT


def s5_layer(u, h0_re, h0_im, lam_re, lam_im, log_dt, b_re, b_im, c_re, c_im, d):
    Bsz, L, _ = u.shape
    f32 = jnp.float32
    uf = u.astype(f32).reshape(Bsz, L, S5_G, S5_H)
    lre, lim = lam_re.astype(f32), lam_im.astype(f32)
    dt = jnp.exp(log_dt.astype(f32))[:, None]
    mag = jnp.exp(lre * dt)
    ab_re = mag * jnp.cos(lim * dt)
    ab_im = mag * jnp.sin(lim * dt)
    e_re, e_im = ab_re - 1.0, ab_im
    den = lre * lre + lim * lim
    co_re = (e_re * lre + e_im * lim) / den
    co_im = (e_im * lre - e_re * lim) / den
    br, bi = b_re.astype(f32), b_im.astype(f32)
    bb_re = co_re[..., None] * br - co_im[..., None] * bi
    bb_im = co_re[..., None] * bi + co_im[..., None] * br
    bu_re = jnp.einsum('blgh,gph->blgp', uf, bb_re)
    bu_im = jnp.einsum('blgh,gph->blgp', uf, bb_im)
    a_re = jnp.broadcast_to(ab_re, (1, L, S5_G, S5_P))
    a_im = jnp.broadcast_to(ab_im, (1, L, S5_G, S5_P))

    def combine(e1, e2):
        a1r, a1i, b1r, b1i = e1
        a2r, a2i, b2r, b2i = e2
        return (a2r * a1r - a2i * a1i,
                a2r * a1i + a2i * a1r,
                a2r * b1r - a2i * b1i + b2r,
                a2r * b1i + a2i * b1r + b2i)

    pr, pim, sr, si = lax.associative_scan(combine, (a_re, a_im, bu_re, bu_im), axis=1)
    h0r = h0_re.astype(f32)[:, None]
    h0i = h0_im.astype(f32)[:, None]
    xr = pr * h0r - pim * h0i + sr
    xi = pr * h0i + pim * h0r + si
    y = (jnp.einsum('blgp,ghp->blgh', xr, c_re.astype(f32))
         - jnp.einsum('blgp,ghp->blgh', xi, c_im.astype(f32))
         + d.astype(f32) * uf)
    return y.reshape(Bsz, L, D_S5).astype(u.dtype), xr[:, -1], xi[:, -1]


def mixer_block(u, conv_buf, h0, s5_re0, s5_im0, pos, p):
    z = u @ p['w_in']
    x_lru = z[..., :D_LRU]
    x_s5 = z[..., D_LRU:D_LRU + D_S5]
    g_a = z[..., D_LRU + D_S5:D_LRU + D_S5 + D_MODEL]
    g_b = z[..., D_LRU + D_S5 + D_MODEL:]
    xc, new_buf = causal_dwconv(x_lru, conv_buf, p['lru_conv_w'], p['lru_conv_b'])
    ya, hT = rg_lru(xc, h0, pos, p['lru_wa'], p['lru_ba'], p['lru_wx'], p['lru_bx'], p['lru_lambda'])
    ya = ya @ p['lru_proj']
    ys, s_re, s_im = s5_layer(x_s5, s5_re0, s5_im0, p['s5_lambda_re'], p['s5_lambda_im'], p['s5_log_dt'],
                              p['s5_b_re'], p['s5_b_im'], p['s5_c_re'], p['s5_c_im'], p['s5_d'])
    v = jax.nn.gelu(ys)
    yb = (v @ p['s5_glu_wv']) * jax.nn.sigmoid(v @ p['s5_glu_wg'])
    merged = jax.nn.sigmoid(g_a) * ya + jax.nn.sigmoid(g_b) * yb
    return merged @ p['w_out'], new_buf, hT, s_re, s_im


def swiglu(u, wg, wu, wd):
    return (jax.nn.silu(u @ wg) * (u @ wu)) @ wd


def setup_inputs(seed: int = 0) -> dict:
    key = jax.random.key(seed)
    ks = jax.random.split(key, 32)
    nrm = jax.random.normal
    f32 = jnp.float32
    a0 = jax.random.uniform(ks[10], (DEPTH, D_LRU), f32, 0.9, 0.999)
    return {
        "x_prompt": nrm(ks[0], (BATCH, SEQ, D_MODEL), f32),
        "x_sample": nrm(ks[1], (DEC_BATCH, DEC_SEQ, D_MODEL), f32),
        "state_lru_conv": nrm(ks[2], (DEPTH, DEC_BATCH, CONV_W - 1, D_LRU), f32) * 0.5,
        "state_lru_h": nrm(ks[3], (DEPTH, DEC_BATCH, D_LRU), f32) * 0.5,
        "state_s5_re": nrm(ks[4], (DEPTH, DEC_BATCH, S5_G, S5_P), f32) * 0.5,
        "state_s5_im": nrm(ks[5], (DEPTH, DEC_BATCH, S5_G, S5_P), f32) * 0.5,
        "norm_mix_g": 1.0 + 0.01 * nrm(ks[6], (DEPTH, D_MODEL), f32),
        "w_in": nrm(ks[7], (DEPTH, D_MODEL, IN_WIDTH), f32) * D_MODEL ** -0.5,
        "lru_conv_w": nrm(ks[8], (DEPTH, CONV_W, D_LRU), f32) * CONV_W ** -0.5,
        "lru_conv_b": 0.01 * nrm(ks[9], (DEPTH, D_LRU), f32),
        "lru_wa": nrm(ks[11], (DEPTH, H_LRU, LRU_BW, LRU_BW), f32) * LRU_BW ** -0.5,
        "lru_ba": 0.01 * nrm(ks[12], (DEPTH, H_LRU, LRU_BW), f32),
        "lru_wx": nrm(ks[13], (DEPTH, H_LRU, LRU_BW, LRU_BW), f32) * LRU_BW ** -0.5,
        "lru_bx": 0.01 * nrm(ks[14], (DEPTH, H_LRU, LRU_BW), f32),
        "lru_lambda": jnp.log(a0) - jnp.log1p(-a0),
        "lru_proj": nrm(ks[15], (DEPTH, D_LRU, D_MODEL), f32) * D_LRU ** -0.5,
        "s5_lambda_re": -0.5 + 0.01 * nrm(ks[16], (DEPTH, S5_G, S5_P), f32),
        "s5_lambda_im": math.pi * jnp.arange(S5_P, dtype=f32)[None, None, :] + 0.01 * nrm(ks[17], (DEPTH, S5_G, S5_P), f32),
        "s5_log_dt": jax.random.uniform(ks[18], (DEPTH, S5_G), f32, math.log(0.001), math.log(0.1)),
        "s5_b_re": nrm(ks[19], (DEPTH, S5_G, S5_P, S5_H), f32) * (2.0 * S5_H) ** -0.5,
        "s5_b_im": nrm(ks[20], (DEPTH, S5_G, S5_P, S5_H), f32) * (2.0 * S5_H) ** -0.5,
        "s5_c_re": nrm(ks[21], (DEPTH, S5_G, S5_H, S5_P), f32) * (2.0 * S5_P) ** -0.5,
        "s5_c_im": nrm(ks[22], (DEPTH, S5_G, S5_H, S5_P), f32) * (2.0 * S5_P) ** -0.5,
        "s5_d": 0.5 * nrm(ks[23], (DEPTH, S5_G, S5_H), f32),
        "s5_glu_wv": nrm(ks[24], (DEPTH, D_S5, D_MODEL), f32) * D_S5 ** -0.5,
        "s5_glu_wg": nrm(ks[25], (DEPTH, D_S5, D_MODEL), f32) * D_S5 ** -0.5,
        "w_out": nrm(ks[26], (DEPTH, D_MODEL, D_MODEL), f32) * D_MODEL ** -0.5,
        "norm_ffn_g": 1.0 + 0.01 * nrm(ks[27], (DEPTH, D_MODEL), f32),
        "ffn_w_gate": nrm(ks[28], (DEPTH, D_MODEL, D_FF), f32) * D_MODEL ** -0.5,
        "ffn_w_up": nrm(ks[29], (DEPTH, D_MODEL, D_FF), f32) * D_MODEL ** -0.5,
        "ffn_w_down": nrm(ks[30], (DEPTH, D_FF, D_MODEL), f32) * D_FF ** -0.5,
        "norm_final_g": 1.0 + 0.01 * nrm(ks[31], (D_MODEL,), f32),
    }


def reference(x_prompt, x_sample, state_lru_conv, state_lru_h, state_s5_re, state_s5_im,
              norm_mix_g, w_in, lru_conv_w, lru_conv_b, lru_wa, lru_ba, lru_wx, lru_bx, lru_lambda,
              lru_proj, s5_lambda_re, s5_lambda_im, s5_log_dt, s5_b_re, s5_b_im, s5_c_re, s5_c_im,
              s5_d, s5_glu_wv, s5_glu_wg, w_out, norm_ffn_g, ffn_w_gate, ffn_w_up, ffn_w_down,
              norm_final_g):
    pos_p = jnp.arange(SEQ, dtype=jnp.int32)
    pos_s = PAST_LEN + jnp.arange(DEC_SEQ, dtype=jnp.int32)
    xp, xs = x_prompt, x_sample
    conv_p_l, h_p_l, sre_p_l, sim_p_l = [], [], [], []
    conv_s_l, h_s_l, sre_s_l, sim_s_l = [], [], [], []
    for l in range(DEPTH):
        p = dict(w_in=w_in[l], lru_conv_w=lru_conv_w[l], lru_conv_b=lru_conv_b[l],
                 lru_wa=lru_wa[l], lru_ba=lru_ba[l], lru_wx=lru_wx[l], lru_bx=lru_bx[l],
                 lru_lambda=lru_lambda[l], lru_proj=lru_proj[l],
                 s5_lambda_re=s5_lambda_re[l], s5_lambda_im=s5_lambda_im[l], s5_log_dt=s5_log_dt[l],
                 s5_b_re=s5_b_re[l], s5_b_im=s5_b_im[l], s5_c_re=s5_c_re[l], s5_c_im=s5_c_im[l],
                 s5_d=s5_d[l], s5_glu_wv=s5_glu_wv[l], s5_glu_wg=s5_glu_wg[l], w_out=w_out[l])
        up = rmsnorm(xp, norm_mix_g[l])
        yp, cb_p, h_p, sr_p, si_p = mixer_block(
            up, jnp.zeros((BATCH, CONV_W - 1, D_LRU), xp.dtype), jnp.zeros((BATCH, D_LRU), jnp.float32),
            jnp.zeros((BATCH, S5_G, S5_P), jnp.float32), jnp.zeros((BATCH, S5_G, S5_P), jnp.float32), pos_p, p)
        xp = xp + yp
        xp = xp + swiglu(rmsnorm(xp, norm_ffn_g[l]), ffn_w_gate[l], ffn_w_up[l], ffn_w_down[l])
        us = rmsnorm(xs, norm_mix_g[l])
        ys, cb_s, h_s, sr_s, si_s = mixer_block(
            us, state_lru_conv[l], state_lru_h[l], state_s5_re[l], state_s5_im[l], pos_s, p)
        xs = xs + ys
        xs = xs + swiglu(rmsnorm(xs, norm_ffn_g[l]), ffn_w_gate[l], ffn_w_up[l], ffn_w_down[l])
        conv_p_l.append(cb_p); h_p_l.append(h_p); sre_p_l.append(sr_p); sim_p_l.append(si_p)
        conv_s_l.append(cb_s); h_s_l.append(h_s); sre_s_l.append(sr_s); sim_s_l.append(si_s)
    y_prompt = rmsnorm(xp, norm_final_g)
    y_sample = rmsnorm(xs, norm_final_g)
    return (y_prompt, y_sample,
            jnp.stack(conv_p_l, 0), jnp.stack(h_p_l, 0), jnp.stack(sre_p_l, 0), jnp.stack(sim_p_l, 0),
            jnp.stack(conv_s_l, 0), jnp.stack(h_s_l, 0), jnp.stack(sre_s_l, 0), jnp.stack(sim_s_l, 0))
```

```cpp
#include <hip/hip_runtime.h>
#include <cstdio>
#include <cstdint>

#ifndef MK_N_LAUNCHES
#define MK_N_LAUNCHES 1
#endif

#define LAS __attribute__((address_space(3)))
#define GAS __attribute__((address_space(1)))
typedef unsigned short bf16_t;
typedef short bf16x8 __attribute__((ext_vector_type(8)));
typedef float f32x4 __attribute__((ext_vector_type(4)));
typedef float f32x2 __attribute__((ext_vector_type(2)));
typedef unsigned u32x4 __attribute__((ext_vector_type(4)));
typedef unsigned u32x2 __attribute__((ext_vector_type(2)));

constexpr int DM = 2048, SEQ = 2048, NB = 4, NS = 128;
constexpr int MP = NB * SEQ;
constexpr int M = MP + NS;
constexpr int MPAD = 8448;
constexpr int DFF = 5632, INW = 7168;
constexpr float EPS = 1e-6f;
constexpr int NPHASE = 9;

constexpr size_t WS_CTL = 0, CTL_ZERO_BYTES = 65536;
constexpr size_t WS_RS1 = 65536;
constexpr size_t WS_PART1 = 131072;
constexpr size_t WS_PART2 = WS_PART1 + (size_t)MPAD * 32 * 4;
constexpr size_t WS_W_IN = 4u << 20;
constexpr size_t WS_V = WS_W_IN;
constexpr size_t WS_W_PROJ = WS_W_IN + (size_t)INW * DM * 2;
constexpr size_t WS_W_GLU = WS_W_PROJ + (size_t)DM * DM * 2;
constexpr size_t WS_W_OUT = WS_W_GLU + (size_t)4096 * 1024 * 2;
constexpr size_t WS_W_GU = WS_W_OUT + (size_t)DM * DM * 2;
constexpr size_t WS_W_DN = WS_W_GU + (size_t)2 * DFF * DM * 2;
constexpr size_t WS_Z = WS_W_DN + (size_t)DM * DFF * 2;
constexpr size_t WS_ACT = WS_Z;
constexpr size_t WS_XB = WS_Z + (size_t)MPAD * INW * 2;
constexpr size_t WS_T = WS_XB;
constexpr size_t WS_HS = WS_XB + (size_t)MPAD * DM * 2;
constexpr size_t WS_X1B = WS_HS;
constexpr size_t WS_END = WS_HS + (size_t)MPAD * DM * 2;
static_assert(WS_PART2 + (size_t)MPAD * 32 * 4 <= WS_W_IN, "ws map");
static_assert(WS_END <= 329380096ull, "ws map exceeds the guaranteed workspace");
constexpr size_t O_Y = 0, O_CONV_P = (size_t)M * DM, O_H_P = O_CONV_P + 24576, O_SRE_P = O_H_P + 8192, O_SIM_P = O_SRE_P + 16384,
                 O_CONV_S = O_SIM_P + 16384, O_H_S = O_CONV_S + 786432, O_SRE_S = O_H_S + 262144, O_SIM_S = O_SRE_S + 524288, O_END = O_SIM_S + 524288;
static_assert(O_END == 19202048, "d_out map");
constexpr int CW_BAR = 4096;

constexpr int RING_BYTES = 131072, LDSCTL_OFF = RING_BYTES, MISC_OFF = LDSCTL_OFF + 320, LDS_BYTES = 147456;

struct Args { const float* in[32]; float* out; unsigned char* ws; int ph_lo, ph_hi, li, pad; };

__device__ __forceinline__ unsigned f2bf(float f) { unsigned u = __builtin_bit_cast(unsigned, f); return (u + 0x7fffu + ((u >> 16) & 1u)) >> 16; }
__device__ __forceinline__ unsigned pk2(float lo, float hi) { return f2bf(lo) | (f2bf(hi) << 16); }
__device__ __forceinline__ unsigned cvt_pk_bf16(float lo, float hi) { unsigned r; asm volatile("v_cvt_pk_bf16_f32 %0, %1, %2" : "=v"(r) : "v"(lo), "v"(hi)); return r; }
__device__ __forceinline__ float bflo(unsigned w) { return __uint_as_float(w << 16); }
__device__ __forceinline__ float bfhi(unsigned w) { return __uint_as_float(w & 0xffff0000u); }
__device__ __forceinline__ float bf2f(unsigned short b) { return __uint_as_float((unsigned)b << 16); }
__device__ __forceinline__ float sigm(float x) { return __builtin_amdgcn_rcpf(1.f + __expf(-x)); }
__device__ __forceinline__ float wave_sum(float v) {
#pragma unroll
    for (int o = 1; o < 64; o <<= 1) v += __shfl_xor(v, o);
    return v;
}
#define LDS_WAIT() asm volatile("s_waitcnt lgkmcnt(0)" ::: "memory")
#define VM_WAIT() asm volatile("s_waitcnt vmcnt(0)" ::: "memory")

namespace pg8 {
constexpr int BM = 256, BK = 64, HALF = 128, HTB = HALF * BK * 2, STAGE_BYTES = 8 * HTB, NXCD = 8, WGM = 8;
__host__ __device__ __forceinline__ int lds_byte(int r, int c) { const int st = (r >> 4) * 2 + (c >> 5), rr = r & 15, cc = c & 31, ob = rr * 64 + cc * 2; return st * 1024 + (ob ^ (((ob >> 9) & 1) << 5)); }
__host__ __device__ __forceinline__ void stage_rc(int b, int& R, int& C) { const int st = b / 1024, sb = b % 1024, swz = sb ^ (((sb >> 9) & 1) << 5); R = (st >> 1) * 16 + swz / 64; C = (st & 1) * 32 + (swz % 64) / 2; }
__host__ __device__ __forceinline__ int perm32(int rho) { const int n = rho >> 4, i = rho & 15; return 8 * (i >> 2) + 4 * n + (i & 3); }

struct Unit { int pm, pn; };
struct Gemm { const bf16_t* A; const bf16_t* Bt; int M, N, K, lda, ldb; };

struct StaticOrder {
    int nM, nN, nwg, G, c;
    __device__ void init(int M_, int N_, int G_, int c_) { nM = M_ / BM; nN = N_ / BM; nwg = nM * nN; G = G_; c = c_; }
    __device__ bool next(int i, Unit& u) const {
        const long L = (long)i * G + c; if (L >= nwg) return false;
        int wgid = (int)L; { const int q = nwg / NXCD, r = nwg % NXCD, xcd = wgid % NXCD, off = wgid / NXCD; wgid = (xcd < r ? xcd * (q + 1) : r * (q + 1) + (xcd - r) * q) + off; }
        const int nig = WGM * nN, gid = wgid / nig, fm = gid * WGM, gsz = (nM - fm) < WGM ? (nM - fm) : WGM;
        u.pm = fm + ((wgid % nig) % gsz); u.pn = (wgid % nig) / gsz; return true;
    }
    __device__ __forceinline__ void a_ready(const Unit&) const {}
    __device__ __forceinline__ void done(const Unit&) const {}
};

template <class Epi, class Sched, bool ALIGN_EPI = false, bool SP2 = false>
__device__ __forceinline__ void gemm_phase(LAS unsigned char* lds, const Gemm g, const Sched& S, const Epi& E) {
    const int tid = threadIdx.x, wid = __builtin_amdgcn_readfirstlane(tid >> 6), lane = tid & 63, wr = wid >> 2, wc = wid & 3, fr = lane & 15, fq = lane >> 4;
    const int K = g.K, nt = K / BK;
    unsigned voffA[2], voffB[2];
#pragma unroll
    for (int i = 0; i < 2; ++i) { int R, C; stage_rc(tid * 16 + i * 8192, R, C); const int Rb = Epi::PERM ? ((R & ~31) + perm32(R & 31)) : R;
        voffA[i] = (unsigned)(R * g.lda + C) * 2u; voffB[i] = (unsigned)(Rb * g.ldb + C) * 2u; }
    const size_t kstep = (size_t)(BK * 2);
    const size_t hstepA = (size_t)HALF * g.lda * 2, hstepB = (size_t)HALF * g.ldb * 2;
    const size_t tstepA = 2 * hstepA, tstepB = 2 * hstepB;
    const unsigned ldsw = (unsigned)wid * 1024u;
    const int aoff = lds_byte(wr * 64 + fr, fq * 8), boff = lds_byte(wc * 32 + fr, fq * 8);
#define PG8_SA(b, h) (((b) * 2 + (h)) * HTB)
#define PG8_SB(b, h) ((4 + (b) * 2 + (h)) * HTB)
#define PG8_STAGE(bufoff, gbase, voff) do { _Pragma("unroll") for (int _i = 0; _i < 2; ++_i) \
        __builtin_amdgcn_global_load_lds((const unsigned*)((const char*)(gbase) + (voff)[_i]), (LAS unsigned*)(lds + (bufoff) + ldsw + _i * 8192), 16, 0, 0); } while (0)
#define PG8_LDA(dst, b, h) do { _Pragma("unroll") for (int m = 0; m < 4; ++m) _Pragma("unroll") for (int k = 0; k < 2; ++k) dst[m][k] = *(const LAS bf16x8*)(lds + PG8_SA(b, h) + aoff + m * 2048 + k * 1024); } while (0)
#define PG8_LDB(dst, b, h) do { _Pragma("unroll") for (int n = 0; n < 2; ++n) _Pragma("unroll") for (int k = 0; k < 2; ++k) dst[n][k] = *(const LAS bf16x8*)(lds + PG8_SB(b, h) + boff + n * 2048 + k * 1024); } while (0)
#define PG8_MMA(ai, bj, At, Bt) do { __builtin_amdgcn_s_setprio(1); _Pragma("unroll") for (int m = 0; m < 4; ++m) _Pragma("unroll") for (int n = 0; n < 2; ++n) _Pragma("unroll") for (int k = 0; k < 2; ++k) \
        acc[ai][bj][m][n] = __builtin_amdgcn_mfma_f32_16x16x32_bf16(Bt[n][k], At[m][k], acc[ai][bj][m][n], 0, 0, 0); __builtin_amdgcn_s_setprio(0); } while (0)
#define PG8_WAIT_V(n) asm volatile("s_waitcnt vmcnt(" #n ")" ::: "memory")
#define PG8_WAIT_L(n) asm volatile("s_waitcnt lgkmcnt(" #n ")" ::: "memory")
#define PG8_BAR __builtin_amdgcn_s_barrier()
#define PG8_SCHED __builtin_amdgcn_sched_barrier(0)
    Unit cur, nxt; int ui = 0;
    if (!S.next(0, cur)) return;
    f32x4 acc[2][2][4][2];
#pragma unroll
    for (int a = 0; a < 2; ++a)
#pragma unroll
        for (int b = 0; b < 2; ++b)
#pragma unroll
            for (int m = 0; m < 4; ++m)
#pragma unroll
                for (int n = 0; n < 2; ++n) acc[a][b][m][n] = (f32x4){0.f, 0.f, 0.f, 0.f};
    bf16x8 At[4][2], B0[2][2], B1[2][2];
    const char* cA = (const char*)g.A + (size_t)cur.pm * tstepA; const char* cB = (const char*)g.Bt + (size_t)cur.pn * tstepB;
    S.a_ready(cur);
    if constexpr (SP2) {
        PG8_STAGE(PG8_SB(0, 0), cB, voffB); PG8_STAGE(PG8_SB(0, 1), cB + hstepB, voffB); PG8_STAGE(PG8_SA(0, 0), cA, voffA); PG8_STAGE(PG8_SA(0, 1), cA + hstepA, voffA);
        if (wr == 1) PG8_BAR;
        PG8_WAIT_V(2); PG8_BAR;
        PG8_STAGE(PG8_SB(1, 0), cB + kstep, voffB); PG8_STAGE(PG8_SA(1, 0), cA + kstep, voffA); PG8_STAGE(PG8_SB(1, 1), cB + hstepB + kstep, voffB);
        PG8_WAIT_V(6); PG8_BAR;
    } else {
        PG8_STAGE(PG8_SB(0, 0), cB, voffB); PG8_STAGE(PG8_SA(0, 0), cA, voffA); PG8_STAGE(PG8_SB(0, 1), cB + hstepB, voffB); PG8_STAGE(PG8_SA(0, 1), cA + hstepA, voffA);
        if (wr == 1) PG8_BAR;
        PG8_WAIT_V(4); PG8_BAR;
        PG8_STAGE(PG8_SB(1, 0), cB + kstep, voffB); PG8_STAGE(PG8_SA(1, 0), cA + kstep, voffA); PG8_STAGE(PG8_SB(1, 1), cB + hstepB + kstep, voffB);
        PG8_WAIT_V(6); PG8_BAR;
    }
    for (;;) {
        const bool has_next = S.next(ui + 1, nxt);
        const char* nA = has_next ? (const char*)g.A + (size_t)nxt.pm * tstepA : cA; const char* nB = has_next ? (const char*)g.Bt + (size_t)nxt.pn * tstepB : cB;
        for (int t = 0; t < nt; t += 2) {
            const bool last = (t == nt - 2);
            const char* a1 = cA + (size_t)(t + 1) * kstep;
            const char* a2 = last ? nA : cA + (size_t)(t + 2) * kstep; const char* b2 = last ? nB : cB + (size_t)(t + 2) * kstep;
            const char* a3 = a2 + kstep; const char* b3 = b2 + kstep;
            if (last && has_next) S.a_ready(nxt);
            if constexpr (SP2) {
            PG8_LDB(B0, 0, 0); PG8_LDB(B1, 0, 1); PG8_SCHED; PG8_LDA(At, 0, 0); PG8_STAGE(PG8_SA(1, 1), a1 + hstepA, voffA);
            PG8_WAIT_V(8); PG8_WAIT_L(0); PG8_BAR; PG8_MMA(0, 0, At, B0); PG8_MMA(0, 1, At, B1); PG8_BAR; PG8_SCHED;
            PG8_LDA(At, 0, 1); PG8_STAGE(PG8_SB(0, 0), b2, voffB); PG8_STAGE(PG8_SB(0, 1), b2 + hstepB, voffB); PG8_STAGE(PG8_SA(0, 0), a2, voffA);
            PG8_WAIT_V(8); PG8_WAIT_L(0); PG8_BAR; PG8_MMA(1, 0, At, B0); PG8_MMA(1, 1, At, B1); PG8_BAR; PG8_SCHED;
            PG8_LDB(B0, 1, 0); PG8_LDB(B1, 1, 1); PG8_SCHED; PG8_LDA(At, 1, 0); PG8_STAGE(PG8_SA(0, 1), a2 + hstepA, voffA);
            PG8_WAIT_V(8); PG8_WAIT_L(0); PG8_BAR; PG8_MMA(0, 0, At, B0); PG8_MMA(0, 1, At, B1); PG8_BAR; PG8_SCHED;
            PG8_LDA(At, 1, 1); PG8_STAGE(PG8_SB(1, 0), b3, voffB); PG8_STAGE(PG8_SB(1, 1), b3 + hstepB, voffB); PG8_STAGE(PG8_SA(1, 0), a3, voffA);
            PG8_WAIT_V(8); PG8_WAIT_L(0); PG8_BAR; PG8_MMA(1, 0, At, B0); PG8_MMA(1, 1, At, B1); PG8_BAR; PG8_SCHED;
            } else {
            PG8_LDB(B0, 0, 0); PG8_SCHED; PG8_LDA(At, 0, 0); PG8_STAGE(PG8_SA(1, 1), a1 + hstepA, voffA);
            PG8_WAIT_L(8); PG8_BAR; PG8_WAIT_L(0); PG8_MMA(0, 0, At, B0); PG8_BAR; PG8_SCHED;
            PG8_LDB(B1, 0, 1); PG8_STAGE(PG8_SB(0, 0), b2, voffB);
            PG8_BAR; PG8_WAIT_L(0); PG8_MMA(0, 1, At, B1); PG8_BAR;
            PG8_LDA(At, 0, 1); PG8_STAGE(PG8_SA(0, 0), a2, voffA);
            PG8_BAR; PG8_WAIT_L(0); PG8_MMA(1, 0, At, B0); PG8_BAR; PG8_SCHED;
            PG8_STAGE(PG8_SB(0, 1), b2 + hstepB, voffB);
            PG8_WAIT_V(6); PG8_BAR; PG8_MMA(1, 1, At, B1); PG8_BAR;
            PG8_LDB(B0, 1, 0); PG8_SCHED; PG8_LDA(At, 1, 0); PG8_STAGE(PG8_SA(0, 1), a2 + hstepA, voffA);
            PG8_WAIT_L(8); PG8_BAR; PG8_WAIT_L(0); PG8_MMA(0, 0, At, B0); PG8_BAR; PG8_SCHED;
            PG8_LDB(B1, 1, 1); PG8_STAGE(PG8_SB(1, 0), b3, voffB);
            PG8_BAR; PG8_WAIT_L(0); PG8_MMA(0, 1, At, B1); PG8_BAR;
            PG8_LDA(At, 1, 1); PG8_STAGE(PG8_SA(1, 0), a3, voffA);
            PG8_BAR; PG8_WAIT_L(0); PG8_MMA(1, 0, At, B0); PG8_BAR; PG8_SCHED;
            PG8_STAGE(PG8_SB(1, 1), b3 + hstepB, voffB);
            PG8_WAIT_V(6); PG8_BAR; PG8_MMA(1, 1, At, B1); PG8_BAR;
            }
        }
        if constexpr (ALIGN_EPI) { if (wr == 0) PG8_BAR; }
        if constexpr (!Epi::AFTER_DRAIN) { E(acc, cur, wr, wc, fr, fq); S.done(cur); }
        if (!has_next) break;
#pragma unroll
        for (int a = 0; a < 2; ++a)
#pragma unroll
            for (int b = 0; b < 2; ++b)
#pragma unroll
                for (int m = 0; m < 4; ++m)
#pragma unroll
                    for (int n = 0; n < 2; ++n) acc[a][b][m][n] = (f32x4){0.f, 0.f, 0.f, 0.f};
        cur = nxt; cA = nA; cB = nB; ++ui;
        if constexpr (ALIGN_EPI) { if (wr == 1) PG8_BAR; }
    }
    PG8_WAIT_V(0);
    if constexpr (!ALIGN_EPI) { if (wr == 0) PG8_BAR; }
    PG8_BAR;
#undef PG8_SA
#undef PG8_SB
#undef PG8_STAGE
#undef PG8_LDA
#undef PG8_LDB
#undef PG8_MMA
#undef PG8_WAIT_V
#undef PG8_WAIT_L
#undef PG8_BAR
#undef PG8_SCHED
}

typedef const f32x4 (&AccRef)[2][2][4][2];
__device__ __forceinline__ u32x4 pack8(f32x4 v0, f32x4 v1) { u32x4 w; w.x = cvt_pk_bf16(v0[0], v0[1]); w.y = cvt_pk_bf16(v0[2], v0[3]); w.z = cvt_pk_bf16(v1[0], v1[1]); w.w = cvt_pk_bf16(v1[2], v1[3]); return w; }
__device__ __forceinline__ void unpack8(u32x4 w, f32x4& v0, f32x4& v1) { v0 = (f32x4){bflo(w.x), bfhi(w.x), bflo(w.y), bfhi(w.y)}; v1 = (f32x4){bflo(w.z), bfhi(w.z), bflo(w.w), bfhi(w.w)}; }
__device__ __forceinline__ f32x4 sig4(f32x4 v) { return (f32x4){sigm(v[0]), sigm(v[1]), sigm(v[2]), sigm(v[3])}; }

struct EpiZ { static constexpr bool PERM = true, AFTER_DRAIN = false;
    bf16_t* Z; const float* rs;
    __device__ __forceinline__ void operator()(AccRef acc, const Unit& u, int wr, int wc, int fr, int fq) const {
        const int row0 = u.pm * BM + wr * 64 + fr, colt = u.pn * BM; const bool gate = colt >= 3072; const int col0 = colt + wc * 32 + 8 * fq;
#pragma unroll
        for (int ai = 0; ai < 2; ++ai)
#pragma unroll
            for (int m = 0; m < 4; ++m) { const int row = row0 + ai * HALF + m * 16; const float r = rs[row]; bf16_t* rowp = Z + (size_t)row * INW + col0;
#pragma unroll
                for (int bj = 0; bj < 2; ++bj) { f32x4 v0 = acc[ai][bj][m][0] * r, v1 = acc[ai][bj][m][1] * r; if (gate) { v0 = sig4(v0); v1 = sig4(v1); }
                    *(u32x4*)(rowp + bj * HALF) = pack8(v0, v1); } }
    }
};
struct EpiT { static constexpr bool PERM = true, AFTER_DRAIN = false;
    bf16_t* T; const bf16_t* Z;
    __device__ __forceinline__ void operator()(AccRef acc, const Unit& u, int wr, int wc, int fr, int fq) const {
        const int row0 = u.pm * BM + wr * 64 + fr, co0 = u.pn * HALF + wc * 32 + 8 * fq;
#pragma unroll
        for (int ai = 0; ai < 2; ++ai)
#pragma unroll
            for (int m = 0; m < 4; ++m) { const int row = row0 + ai * HALF + m * 16;
                f32x4 g0, g1; unpack8(*(const u32x4*)(Z + (size_t)row * INW + 5120 + co0), g0, g1);
                const f32x4 t0 = acc[ai][0][m][0] * sig4(acc[ai][1][m][0]) * g0, t1 = acc[ai][0][m][1] * sig4(acc[ai][1][m][1]) * g1;
                *(u32x4*)(T + (size_t)row * DM + co0) = pack8(t0, t1); }
    }
};
struct EpiMerged { static constexpr bool PERM = true, AFTER_DRAIN = false;
    bf16_t* T; const bf16_t* Z;
    __device__ __forceinline__ void operator()(AccRef acc, const Unit& u, int wr, int wc, int fr, int fq) const {
        const int row0 = u.pm * BM + wr * 64 + fr, col0 = u.pn * BM + wc * 32 + 8 * fq;
#pragma unroll
        for (int ai = 0; ai < 2; ++ai)
#pragma unroll
            for (int m = 0; m < 4; ++m) { const int row = row0 + ai * HALF + m * 16;
#pragma unroll
                for (int bj = 0; bj < 2; ++bj) { const int c = col0 + bj * HALF; f32x4 g0, g1, t0, t1;
                    unpack8(*(const u32x4*)(Z + (size_t)row * INW + 3072 + c), g0, g1); bf16_t* tp = T + (size_t)row * DM + c; unpack8(*(const u32x4*)tp, t0, t1);
                    *(u32x4*)tp = pack8(acc[ai][bj][m][0] * g0 + t0, acc[ai][bj][m][1] * g1 + t1); } }
    }
};
template <bool WITH_BF16> struct EpiRes { static constexpr bool PERM = false, AFTER_DRAIN = false;
    const float* base_p; const float* base_s; float* out; bf16_t* outb; float* part;
    __device__ __forceinline__ void operator()(AccRef acc, const Unit& u, int wr, int wc, int fr, int fq) const {
        const int row0 = u.pm * BM + wr * 64 + fr, col0 = u.pn * BM + wc * 32 + 4 * fq;
#pragma unroll
        for (int ai = 0; ai < 2; ++ai)
#pragma unroll
            for (int m = 0; m < 4; ++m) { const int row = row0 + ai * HALF + m * 16; const bool valid = row < M;
                const float* br = row < MP ? base_p + (size_t)row * DM : base_s + (size_t)(row - MP) * DM; float ss = 0.f;
#pragma unroll
                for (int bj = 0; bj < 2; ++bj)
#pragma unroll
                    for (int n = 0; n < 2; ++n) { const int c = col0 + bj * HALF + n * 16; f32x4 v = acc[ai][bj][m][n];
                        if (valid) { v += *(const f32x4*)(br + c); *(f32x4*)(out + (size_t)row * DM + c) = v; }
                        ss += (v[0] * v[0] + v[1] * v[1]) + (v[2] * v[2] + v[3] * v[3]);
                        if (WITH_BF16) { u32x2 w; w.x = cvt_pk_bf16(v[0], v[1]); w.y = cvt_pk_bf16(v[2], v[3]); *(u32x2*)(outb + (size_t)row * DM + c) = w; } }
                ss += __shfl_xor(ss, 16); ss += __shfl_xor(ss, 32);
                if (fq == 0) part[(size_t)row * 32 + u.pn * 4 + wc] = ss; }
    }
};
struct EpiAct { static constexpr bool PERM = true, AFTER_DRAIN = false;
    bf16_t* ACT; const float* part;
    __device__ __forceinline__ void operator()(AccRef acc, const Unit& u, int wr, int wc, int fr, int fq) const {
        const int row0 = u.pm * BM + wr * 64 + fr, co0 = u.pn * HALF + wc * 32 + 8 * fq;
#pragma unroll
        for (int ai = 0; ai < 2; ++ai)
#pragma unroll
            for (int m = 0; m < 4; ++m) { const int row = row0 + ai * HALF + m * 16;
                const f32x4 p0 = *(const f32x4*)(part + (size_t)row * 32 + 8 * fq), p1 = *(const f32x4*)(part + (size_t)row * 32 + 8 * fq + 4);
                float ss = ((p0[0] + p0[1]) + (p0[2] + p0[3])) + ((p1[0] + p1[1]) + (p1[2] + p1[3])); ss += __shfl_xor(ss, 16); ss += __shfl_xor(ss, 32);
                const float r = rsqrtf(ss * (1.f / DM) + EPS);
                const f32x4 g0 = acc[ai][0][m][0] * r, g1 = acc[ai][0][m][1] * r, u0 = acc[ai][1][m][0] * r, u1 = acc[ai][1][m][1] * r;
                *(u32x4*)(ACT + (size_t)row * DFF + co0) = pack8(g0 * sig4(g0) * u0, g1 * sig4(g1) * u1); }
    }
};
}

#define XB_TMO      128
#define XB_XCNT(j)  (256  + 64 * (j))
#define XB_XSUB(j)  (1280 + 64 * (j))
#define XB_XGEN(j)  (2304 + 64 * (j))
#define XB_TOP      3328
#define XB_TOPGEN   3392
#define XCD_BAR_WORDS 3456
#define XB_SPIN_CAP (1u << 22)
__device__ __forceinline__ unsigned xb_ld(unsigned* p)              { return __hip_atomic_load(p, __ATOMIC_RELAXED, __HIP_MEMORY_SCOPE_AGENT); }
__device__ __forceinline__ unsigned xb_add(unsigned* p, unsigned v) { return __hip_atomic_fetch_add(p, v, __ATOMIC_RELAXED, __HIP_MEMORY_SCOPE_AGENT); }
__device__ __forceinline__ unsigned xb_xcc_id() { return (unsigned)__builtin_amdgcn_s_getreg((3 << 11) | 20) & 0xFu; }
#define XB_SPIN(cond, bar) do { unsigned _sp = 0; while (cond) { __builtin_amdgcn_s_sleep(1); \
    if ((++_sp & 255u) == 0u) { if (xb_ld(&(bar)[XB_TMO])) break; if (_sp > XB_SPIN_CAP) { atomicAdd(&(bar)[XB_TMO], 1u); break; } } } } while (0)
struct XcdBarrier { unsigned* bar; unsigned x; volatile LAS unsigned* st; };
__device__ __forceinline__ XcdBarrier xcd_barrier_post(unsigned* bar, volatile LAS unsigned* st) {
    XcdBarrier b; b.bar = bar; b.x = xb_xcc_id(); b.st = st;
    if (threadIdx.x == 0) (void)xb_add(&bar[XB_XCNT(b.x)], 1u);
    return b;
}
__device__ __forceinline__ void xcd_barrier_complete(unsigned* bar, unsigned x, unsigned& nloc, unsigned& nx) {
    const unsigned G = gridDim.x * gridDim.y * gridDim.z;
    unsigned sum, cnt, mine, sp = 0u;
    for (;;) {
        sum = 0u; cnt = 0u; mine = 0u;
#pragma unroll
        for (unsigned j = 0; j < 16; ++j) { const unsigned c = xb_ld(&bar[XB_XCNT(j)]); sum += c; cnt += (c > 0u) ? 1u : 0u; mine = (j == x) ? c : mine; }
        if (sum == G) break;
        __builtin_amdgcn_s_sleep(1);
        if ((++sp & 255u) == 0u) { if (xb_ld(&bar[XB_TMO])) break; if (sp > XB_SPIN_CAP) { atomicAdd(&bar[XB_TMO], 1u); break; } }
    }
    nloc = mine > 0u ? mine : 1u; nx = cnt > 0u ? cnt : 1u;
}
__device__ __forceinline__ void xcd_barrier(const XcdBarrier& b) {
    asm volatile("s_waitcnt vmcnt(0)" ::: "memory");
    __syncthreads();
    if (threadIdx.x == 0) {
        unsigned* bar = b.bar;
        __builtin_amdgcn_s_waitcnt(0);
        unsigned nloc = b.st[0], nx = b.st[1];
        if (nloc == 0u) { xcd_barrier_complete(bar, b.x, nloc, nx); b.st[0] = nloc; b.st[1] = nx; }
        const unsigned old = xb_add(&bar[XB_XSUB(b.x)], 1u);
        const unsigned gen = old / nloc;
        if (old + 1u == (gen + 1u) * nloc) {
            __builtin_amdgcn_fence(__ATOMIC_RELEASE, "agent");
            asm volatile("s_waitcnt vmcnt(0)" ::: "memory");
            const unsigned og = xb_add(&bar[XB_TOP], 1u);
            const unsigned tg = og / nx;
            if (og + 1u == (tg + 1u) * nx) xb_add(&bar[XB_TOPGEN], 1u);
            else XB_SPIN(xb_ld(&bar[XB_TOPGEN]) == tg, bar);
            __builtin_amdgcn_fence(__ATOMIC_ACQUIRE, "agent");
            xb_add(&bar[XB_XGEN(b.x)], 1u);
            asm volatile("s_waitcnt vmcnt(0)" ::: "memory");
        } else {
            XB_SPIN(xb_ld(&bar[XB_XGEN(b.x)]) == gen, bar);
            __builtin_amdgcn_fence(__ATOMIC_ACQUIRE, "agent");
            asm volatile("s_waitcnt vmcnt(0)" ::: "memory");
        }
    }
    __syncthreads();
}

__device__ __forceinline__ void p0_transpose_item(const float* W, int K, int N, const float* gs, bf16_t* WT, int mode, int which, LAS float* scr, int item, int lane) {
    const int nblk = N / 32, kb = item / nblk, nb = item % nblk, k0 = 64 * kb, n0 = 32 * nb;
#pragma unroll 8
    for (int i = 0; i < 32; ++i) { const int kk = 2 * i + (lane >> 5); float v = W[(size_t)(k0 + kk) * N + n0 + (lane & 31)]; if (gs) v *= gs[k0 + kk]; scr[kk * 33 + (lane & 31)] = v; }
    LDS_WAIT(); asm volatile("" ::: "memory");
    const int c = lane & 7;
#pragma unroll
    for (int j = 0; j < 4; ++j) { const int n = (lane >> 3) + 8 * j; const LAS float* s = scr + (8 * c) * 33 + n;
        u32x4 o; o.x = pk2(s[0 * 33], s[1 * 33]); o.y = pk2(s[2 * 33], s[3 * 33]); o.z = pk2(s[4 * 33], s[5 * 33]); o.w = pk2(s[6 * 33], s[7 * 33]);
        const int gn = n0 + n; const int drow = mode ? ((gn >> 7) * 256 + which * 128 + (gn & 127)) : gn;
        *(GAS u32x4*)(WT + (size_t)drow * K + k0 + 8 * c) = o; }
    LDS_WAIT(); asm volatile("" ::: "memory");
}
__device__ __forceinline__ void p0_prologue(const Args& A, LAS unsigned char* lds, int vcu, int G, int wave, int lane) {
    LAS float* scr = (LAS float*)(lds + wave * 16384);
    const int gw = vcu * 8 + wave, NGW = G * 8;
    unsigned char* ws = A.ws;
    constexpr int I_IN = (DM / 64) * (INW / 32), I_SQ = (DM / 64) * (DM / 32), I_GLU = (1024 / 64) * (DM / 32), I_FF = (DM / 64) * (DFF / 32), I_DN = (DFF / 64) * (DM / 32);
    constexpr int NITEMS = I_IN + 2 * I_SQ + 2 * I_GLU + 2 * I_FF + I_DN;
    for (int it = gw; it < NITEMS; it += NGW) {
        int r = it;
        if (r < I_IN) { p0_transpose_item(A.in[7], DM, INW, A.in[6], (bf16_t*)(ws + WS_W_IN), 0, 0, scr, r, lane); continue; } r -= I_IN;
        if (r < I_FF) { p0_transpose_item(A.in[28], DM, DFF, A.in[27], (bf16_t*)(ws + WS_W_GU), 1, 0, scr, r, lane); continue; } r -= I_FF;
        if (r < I_FF) { p0_transpose_item(A.in[29], DM, DFF, A.in[27], (bf16_t*)(ws + WS_W_GU), 1, 1, scr, r, lane); continue; } r -= I_FF;
        if (r < I_DN) { p0_transpose_item(A.in[30], DFF, DM, nullptr, (bf16_t*)(ws + WS_W_DN), 0, 0, scr, r, lane); continue; } r -= I_DN;
        if (r < I_SQ) { p0_transpose_item(A.in[15], DM, DM, nullptr, (bf16_t*)(ws + WS_W_PROJ), 0, 0, scr, r, lane); continue; } r -= I_SQ;
        if (r < I_SQ) { p0_transpose_item(A.in[26], DM, DM, nullptr, (bf16_t*)(ws + WS_W_OUT), 0, 0, scr, r, lane); continue; } r -= I_SQ;
        if (r < I_GLU) { p0_transpose_item(A.in[24], 1024, DM, nullptr, (bf16_t*)(ws + WS_W_GLU), 1, 0, scr, r, lane); continue; } r -= I_GLU;
        p0_transpose_item(A.in[25], 1024, DM, nullptr, (bf16_t*)(ws + WS_W_GLU), 1, 1, scr, r, lane);
    }
    bf16_t* XB = (bf16_t*)(ws + WS_XB); float* rs1 = (float*)(ws + WS_RS1);
    for (int m = gw; m < M; m += NGW) {
        const float* xrow = m < MP ? A.in[0] + (size_t)m * DM : A.in[1] + (size_t)(m - MP) * DM;
        const GAS f32x4* xr = (const GAS f32x4*)xrow + lane;
        f32x4 v[8]; float s = 0.f;
#pragma unroll
        for (int j = 0; j < 8; ++j) { v[j] = xr[64 * j]; s += (v[j][0] * v[j][0] + v[j][1] * v[j][1]) + (v[j][2] * v[j][2] + v[j][3] * v[j][3]); }
        s = wave_sum(s);
        GAS u32x2* o8 = (GAS u32x2*)(XB + (size_t)m * DM) + lane;
#pragma unroll
        for (int j = 0; j < 8; ++j) { u32x2 w; w.x = pk2(v[j][0], v[j][1]); w.y = pk2(v[j][2], v[j][3]); o8[64 * j] = w; }
        if (lane == 0) rs1[m] = rsqrtf(s * (1.f / DM) + EPS);
    }
}

__device__ __forceinline__ void lru_item(const Args& A, LAS unsigned char* lds, int item, bool sample, int tid, int lane, int w) {
    int b, h, s;
    if (!sample) { b = item >> 6; h = (item >> 3) & 7; s = item & 7; } else { b = 0; h = item >> 3; s = item & 7; }
    const int c0h = s * 32, c0 = h * 256 + c0h;
    LAS unsigned char* XA = lds;
    LAS float* XF = (LAS float*)(lds + 65536);
    LAS float* PRE = (LAS float*)(lds + 81920);
    LAS float* SEG = (LAS float*)(lds + 116736);
    LAS unsigned short* HSL = (LAS unsigned short*)(lds + 120832);
    const bf16_t* Z = (const bf16_t*)(A.ws + WS_Z);
    bf16_t* HS = (bf16_t*)(A.ws + WS_HS);
    const int nf = w & 3, mh = w >> 2, l15 = lane & 15, l4 = lane >> 4;
    bf16x8 Bf[8];
    {
        const float* Wsrc = ((nf < 2) ? A.in[10] : A.in[12]) + (size_t)h * 65536 + c0h + 16 * (nf & 1) + l15;
#pragma unroll
        for (int ks = 0; ks < 8; ++ks) { const float* p = Wsrc + (size_t)(32 * ks + 8 * l4) * 256;
            u32x4 t; t.x = pk2(p[0], p[256]); t.y = pk2(p[512], p[768]); t.z = pk2(p[1024], p[1280]); t.w = pk2(p[1536], p[1792]); Bf[ks] = __builtin_bit_cast(bf16x8, t); }
    }
    const float pbias = ((nf < 2) ? A.in[11] : A.in[13])[h * 256 + c0h + 16 * (nf & 1) + l15];
    const int sc = tid & 31, sg = tid >> 5;
    const float sp = log1pf(expf(-A.in[14][c0 + sc]));
    const int cg = tid & 31, rg = tid >> 5, gch = h * 256 + cg * 8;
    float cw[4][8], cb[8];
#pragma unroll
    for (int e = 0; e < 8; ++e) { cb[e] = A.in[9][gch + e];
#pragma unroll
        for (int k = 0; k < 4; ++k) cw[k][e] = A.in[8][k * 2048 + gch + e]; }
    const bool insl = (cg >> 2) == s;
    float carry = 0.f;
    const int nch = sample ? 1 : 16;
    for (int ch = 0; ch < nch; ++ch) {
        const int t0 = ch * 128; const int grow0 = sample ? MP : b * SEQ + t0;
        if (!sample) {
            u32x4 raw[11];
#pragma unroll
            for (int jj = 0; jj < 11; ++jj) { const int t = t0 + rg * 8 - 3 + jj; raw[jj] = (u32x4){0u, 0u, 0u, 0u}; if (t >= 0) raw[jj] = *(const u32x4*)(Z + (size_t)(b * SEQ + t) * INW + gch); }
#pragma unroll
            for (int j = 0; j < 8; ++j) {
                float xc[8];
#pragma unroll
                for (int e = 0; e < 8; ++e) xc[e] = cb[e];
#pragma unroll
                for (int k = 0; k < 4; ++k) { f32x4 a0, a1; pg8::unpack8(raw[j + k], a0, a1);
#pragma unroll
                    for (int e = 0; e < 4; ++e) { xc[e] += cw[k][e] * a0[e]; xc[4 + e] += cw[k][4 + e] * a1[e]; } }
                const int row = rg * 8 + j;
                u32x4 o; o.x = pk2(xc[0], xc[1]); o.y = pk2(xc[2], xc[3]); o.z = pk2(xc[4], xc[5]); o.w = pk2(xc[6], xc[7]);
                *(LAS u32x4*)(XA + row * 512 + ((cg ^ (row & 15)) << 4)) = o;
                if (insl) { LAS f32x4* xf = (LAS f32x4*)(XF + row * 32 + (cg & 3) * 8); xf[0] = (f32x4){xc[0], xc[1], xc[2], xc[3]}; xf[1] = (f32x4){xc[4], xc[5], xc[6], xc[7]}; }
            }
            if (ch == 15 && rg == 15 && insl) {
#pragma unroll
                for (int k = 0; k < 3; ++k) { f32x4 a0, a1; pg8::unpack8(raw[8 + k], a0, a1); float* o = A.out + O_CONV_P + (size_t)(b * 3 + k) * 2048 + gch; *(f32x4*)o = a0; *(f32x4*)(o + 4) = a1; }
            }
        } else {
#pragma unroll 2
            for (int j = 0; j < 8; ++j) {
                const int row = rg * 8 + j;
                f32x4 x0, x1; pg8::unpack8(*(const u32x4*)(Z + (size_t)(MP + row) * INW + gch), x0, x1);
                f32x4 bq[3][2];
#pragma unroll
                for (int k = 0; k < 3; ++k) { const float* p = A.in[2] + (size_t)(row * 3 + k) * 2048 + gch; bq[k][0] = *(const f32x4*)p; bq[k][1] = *(const f32x4*)(p + 4); }
                float xc[8];
#pragma unroll
                for (int e = 0; e < 4; ++e) {
                    xc[e] = cb[e] + cw[0][e] * bq[0][0][e] + cw[1][e] * bq[1][0][e] + cw[2][e] * bq[2][0][e] + cw[3][e] * x0[e];
                    xc[4 + e] = cb[4 + e] + cw[0][4 + e] * bq[0][1][e] + cw[1][4 + e] * bq[1][1][e] + cw[2][4 + e] * bq[2][1][e] + cw[3][4 + e] * x1[e]; }
                u32x4 o; o.x = pk2(xc[0], xc[1]); o.y = pk2(xc[2], xc[3]); o.z = pk2(xc[4], xc[5]); o.w = pk2(xc[6], xc[7]);
                *(LAS u32x4*)(XA + row * 512 + ((cg ^ (row & 15)) << 4)) = o;
                if (insl) { LAS f32x4* xf = (LAS f32x4*)(XF + row * 32 + (cg & 3) * 8); xf[0] = (f32x4){xc[0], xc[1], xc[2], xc[3]}; xf[1] = (f32x4){xc[4], xc[5], xc[6], xc[7]};
                    float* o0 = A.out + O_CONV_S + (size_t)(row * 3) * 2048 + gch;
                    *(f32x4*)o0 = bq[1][0]; *(f32x4*)(o0 + 4) = bq[1][1]; *(f32x4*)(o0 + 2048) = bq[2][0]; *(f32x4*)(o0 + 2052) = bq[2][1]; *(f32x4*)(o0 + 4096) = x0; *(f32x4*)(o0 + 4100) = x1; }
            }
        }
        __syncthreads();
#pragma unroll
        for (int mf = 0; mf < 4; ++mf) {
            const int R0 = 64 * mh + 16 * mf; f32x4 acc = (f32x4){0.f, 0.f, 0.f, 0.f};
            const int row = R0 + l15;
#pragma unroll
            for (int ks = 0; ks < 8; ++ks) { const bf16x8 Af = *(const LAS bf16x8*)(XA + row * 512 + (((ks * 4 + l4) ^ (row & 15)) << 4));
                acc = __builtin_amdgcn_mfma_f32_16x16x32_bf16(Af, Bf[ks], acc, 0, 0, 0); }
#pragma unroll
            for (int r = 0; r < 4; ++r) PRE[(R0 + l4 * 4 + r) * 68 + nf * 16 + l15] = acc[r] + pbias;
        }
        __syncthreads();
        float hrun = 0.f, prun = 1.f;
#pragma unroll 2
        for (int j = 0; j < 8; ++j) {
            const int row = sg * 8 + j;
            const float r = sigm(PRE[row * 68 + sc]), ig = sigm(PRE[row * 68 + 32 + sc]), xcv = XF[row * 32 + sc];
            const float la = -8.f * r * sp; const float a = expf(la);
            float mult = sqrtf(-expm1f(2.f * la));
            if (!sample && ch == 0 && row == 0) mult = 1.f;
            const float bt = mult * ig * xcv;
            if (!sample) { hrun = a * hrun + bt; prun *= a; PRE[row * 68 + sc] = hrun; PRE[row * 68 + 32 + sc] = prun; }
            else { const float h0 = A.in[3][(size_t)row * 2048 + c0 + sc]; const float hv = a * h0 + bt; PRE[row * 68 + sc] = hv; PRE[row * 68 + 32 + sc] = 0.f;
                   A.out[O_H_S + (size_t)row * 2048 + c0 + sc] = hv; }
        }
        float mycin = 0.f;
        if (!sample) {
            SEG[(sg * 32 + sc) * 2] = prun; SEG[(sg * 32 + sc) * 2 + 1] = hrun;
            __syncthreads();
            float cin = carry;
#pragma unroll
            for (int jj = 0; jj < 16; ++jj) { if (jj == sg) mycin = cin; cin = SEG[(jj * 32 + sc) * 2] * cin + SEG[(jj * 32 + sc) * 2 + 1]; }
            carry = cin;
        }
#pragma unroll
        for (int j = 0; j < 8; ++j) { const int row = sg * 8 + j; const float hv = PRE[row * 68 + sc] + PRE[row * 68 + 32 + sc] * mycin; HSL[row * 32 + sc] = (unsigned short)f2bf(hv); }
        __syncthreads();
        { const int row = tid >> 2, q = tid & 3; const u32x4 v = *(const LAS u32x4*)(HSL + row * 32 + q * 8); *(u32x4*)(HS + (size_t)(grow0 + row) * DM + c0 + q * 8) = v; }
        if (!sample && ch == 15 && sg == 0) A.out[O_H_P + (size_t)b * 2048 + c0 + sc] = carry;
    }
}

__device__ __forceinline__ float gelu_tanh(float x) {
    const float u = 0.7978845608028654f * (x + 0.044715f * x * x * x);
    const float t = 1.f - 2.f * __builtin_amdgcn_rcpf(1.f + __expf(2.f * u));
    return 0.5f * x * (1.f + t);
}
__device__ __forceinline__ void s5_item(const Args& A, LAS unsigned char* lds, int item, bool sample, int tid, int lane, int w) {
    int b, g; if (!sample) { b = item >> 6; g = item & 63; } else { b = 0; g = item; }
    LAS float* BU = (LAS float*)lds;
    LAS unsigned short* XBL = (LAS unsigned short*)lds;
    LAS unsigned short* BB = (LAS unsigned short*)(lds + 67584);
    LAS float* SEGX = (LAS float*)(lds + 71680);
    const bf16_t* Z = (const bf16_t*)(A.ws + WS_Z);
    bf16_t* V = (bf16_t*)(A.ws + WS_V);
    const int l15 = lane & 15, l4 = lane >> 4;
    const float dt = expf(A.in[18][g]);
    float ar, ai;
    { const float lre = A.in[16][g * 64 + lane], lim = A.in[17][g * 64 + lane]; const float mag = expf(lre * dt); float sn, cs; sincosf(lim * dt, &sn, &cs); ar = mag * cs; ai = mag * sn; }
    float a16r, a16i;
    { float r = ar, i = ai;
#pragma unroll
      for (int q = 0; q < 4; ++q) { const float nr = r * r - i * i, ni = 2.f * r * i; r = nr; i = ni; }
      a16r = r; a16i = i; }
    {
        const int n = tid >> 2, p = n & 63, im = n >> 6;
        const float lre = A.in[16][g * 64 + p], lim = A.in[17][g * 64 + p]; const float mag = expf(lre * dt); float sn, cs; sincosf(lim * dt, &sn, &cs);
        const float e_re = mag * cs - 1.f, e_im = mag * sn, den = lre * lre + lim * lim;
        const float co_re = (e_re * lre + e_im * lim) / den, co_im = (e_im * lre - e_re * lim) / den;
#pragma unroll
        for (int q = 0; q < 4; ++q) { const int hh = (tid & 3) * 4 + q; const float br = A.in[19][(size_t)(g * 64 + p) * 16 + hh], bi = A.in[20][(size_t)(g * 64 + p) * 16 + hh];
            BB[n * 16 + hh] = (unsigned short)f2bf(im ? (co_re * bi + co_im * br) : (co_re * br - co_im * bi)); }
    }
    __syncthreads();
    bf16x8 Bf[8], Cf[4];
    const bf16x8 zero8 = (bf16x8){0, 0, 0, 0, 0, 0, 0, 0};
#pragma unroll
    for (int nfi = 0; nfi < 8; ++nfi) { Bf[nfi] = zero8; if (l4 < 2) Bf[nfi] = *(const LAS bf16x8*)(BB + (16 * nfi + l15) * 16 + 8 * l4); }
#pragma unroll
    for (int ks = 0; ks < 4; ++ks) { const float* src = (ks < 2 ? A.in[21] : A.in[22]) + (size_t)(g * 16 + l15) * 64 + 32 * (ks & 1) + 8 * l4; const float sgn = ks < 2 ? 1.f : -1.f;
        u32x4 t; t.x = pk2(sgn * src[0], sgn * src[1]); t.y = pk2(sgn * src[2], sgn * src[3]); t.z = pk2(sgn * src[4], sgn * src[5]); t.w = pk2(sgn * src[6], sgn * src[7]); Cf[ks] = __builtin_bit_cast(bf16x8, t); }
    const float dv = A.in[23][g * 16 + l15];
    float cr = 0.f, ci = 0.f;
    const int nch = sample ? 1 : 16;
    for (int ch = 0; ch < nch; ++ch) {
        const int grow0 = sample ? MP : b * SEQ + ch * 128;
        bf16x8 Af = zero8; if (l4 < 2) Af = *(const bf16x8*)(Z + (size_t)(grow0 + 16 * w + l15) * INW + 2048 + 16 * g + 8 * l4);
#pragma unroll
        for (int nfi = 0; nfi < 8; ++nfi) { const f32x4 acc = __builtin_amdgcn_mfma_f32_16x16x32_bf16(Af, Bf[nfi], (f32x4){0.f, 0.f, 0.f, 0.f}, 0, 0, 0);
#pragma unroll
            for (int r = 0; r < 4; ++r) BU[(16 * w + l4 * 4 + r) * 132 + 16 * nfi + l15] = acc[r]; }
        LDS_WAIT();
        float xlr[16], xli[16];
        if (!sample) {
            float xr = 0.f, xi = 0.f;
#pragma unroll
            for (int j = 0; j < 16; ++j) { const float br = BU[(16 * w + j) * 132 + lane], bi = BU[(16 * w + j) * 132 + 64 + lane];
                const float nr = ar * xr - ai * xi + br, ni = ar * xi + ai * xr + bi; xr = nr; xi = ni; xlr[j] = xr; xli[j] = xi; }
            SEGX[(w * 64 + lane) * 2] = xr; SEGX[(w * 64 + lane) * 2 + 1] = xi;
            __syncthreads();
            float mr = 0.f, mi = 0.f, c_r = cr, c_i = ci;
#pragma unroll
            for (int jj = 0; jj < 8; ++jj) { if (jj == w) { mr = c_r; mi = c_i; } const float sr = SEGX[(jj * 64 + lane) * 2], si = SEGX[(jj * 64 + lane) * 2 + 1];
                const float nr = a16r * c_r - a16i * c_i + sr, ni = a16r * c_i + a16i * c_r + si; c_r = nr; c_i = ni; }
            cr = c_r; ci = c_i;
            float pr = ar, pi = ai;
#pragma unroll
            for (int j = 0; j < 16; ++j) { const float xr2 = xlr[j] + pr * mr - pi * mi, xi2 = xli[j] + pr * mi + pi * mr; const float npr = pr * ar - pi * ai, npi = pr * ai + pi * ar; pr = npr; pi = npi;
                XBL[(16 * w + j) * 264 + lane] = (unsigned short)f2bf(xr2); XBL[(16 * w + j) * 264 + 64 + lane] = (unsigned short)f2bf(xi2); }
        } else {
#pragma unroll
            for (int j = 0; j < 16; ++j) { const int i = 16 * w + j; const float br = BU[i * 132 + lane], bi = BU[i * 132 + 64 + lane];
                const size_t so = ((size_t)i * 64 + g) * 64 + lane; const float x0r = A.in[4][so], x0i = A.in[5][so];
                xlr[j] = ar * x0r - ai * x0i + br; xli[j] = ar * x0i + ai * x0r + bi; A.out[O_SRE_S + so] = xlr[j]; A.out[O_SIM_S + so] = xli[j]; }
#pragma unroll
            for (int j = 0; j < 16; ++j) { XBL[(16 * w + j) * 264 + lane] = (unsigned short)f2bf(xlr[j]); XBL[(16 * w + j) * 264 + 64 + lane] = (unsigned short)f2bf(xli[j]); }
        }
        LDS_WAIT();
        f32x4 ya = (f32x4){0.f, 0.f, 0.f, 0.f};
#pragma unroll
        for (int ks = 0; ks < 4; ++ks) { const bf16x8 Ax = *(const LAS bf16x8*)(XBL + (16 * w + l15) * 264 + 32 * ks + 8 * l4); ya = __builtin_amdgcn_mfma_f32_16x16x32_bf16(Ax, Cf[ks], ya, 0, 0, 0); }
#pragma unroll
        for (int r = 0; r < 4; ++r) { const size_t grow = (size_t)(grow0 + 16 * w + l4 * 4 + r); const float uu = bf2f(Z[grow * INW + 2048 + 16 * g + l15]);
            V[grow * 1024 + 16 * g + l15] = (bf16_t)f2bf(gelu_tanh(ya[r] + dv * uu)); }
        __syncthreads();
    }
    if (!sample && w == 0) { A.out[O_SRE_P + (size_t)(b * 64 + g) * 64 + lane] = cr; A.out[O_SIM_P + (size_t)(b * 64 + g) * 64 + lane] = ci; }
}

__global__ void __launch_bounds__(512, 2) hyb_fwd(Args args) {
    extern __shared__ __attribute__((aligned(16))) unsigned char lds_raw[];
    LAS unsigned char* lds = (LAS unsigned char*)lds_raw;
    volatile LAS unsigned* MISC = (volatile LAS unsigned*)(lds + MISC_OFF);
    const int tid = threadIdx.x, lane = tid & 63, wave = __builtin_amdgcn_readfirstlane(tid >> 6);
    const int G = gridDim.x, bx = blockIdx.x;
    const int vcu = (G % 8 == 0) ? (bx % 8) * (G / 8) + bx / 8 : bx;
    unsigned char* ws = args.ws;
    for (int u = tid; u < (LDS_BYTES - LDSCTL_OFF) / 4; u += 512) ((LAS unsigned*)(lds + LDSCTL_OFF))[u] = 0u;
    __syncthreads();
    XcdBarrier bar; bar.bar = (unsigned*)(ws + WS_CTL) + CW_BAR; bar.x = 0; bar.st = nullptr;
    if (MK_N_LAUNCHES == 1) bar = xcd_barrier_post((unsigned*)(ws + WS_CTL) + CW_BAR, MISC + 8);
    const int lo = args.ph_lo, hi = args.ph_hi;
#define IN(k) (lo <= (k) && (k) < hi)
#define SEAM(k) do { if (IN(k) && IN((k) + 1)) xcd_barrier(bar); } while (0)
    bf16_t* Zb = (bf16_t*)(ws + WS_Z); bf16_t* Tb = (bf16_t*)(ws + WS_T);
    float* part1 = (float*)(ws + WS_PART1); float* part2 = (float*)(ws + WS_PART2);

    if (IN(0)) { p0_prologue(args, lds, vcu, G, wave, lane); SEAM(0); }
    if (IN(1)) {
        pg8::Gemm g{(const bf16_t*)(ws + WS_XB), (const bf16_t*)(ws + WS_W_IN), MPAD, INW, DM, DM, DM}; pg8::StaticOrder S; S.init(MPAD, INW, G, bx);
        pg8::EpiZ E{Zb, (const float*)(ws + WS_RS1)};
        pg8::gemm_phase<pg8::EpiZ, pg8::StaticOrder, true, true>(lds, g, S, E);
        SEAM(1);
    }
    if (IN(2)) {
        for (int it = bx; it < 256; it += G) { __syncthreads(); lru_item(args, lds, it, false, tid, lane, wave); }
        for (int it = bx; it < 256; it += G) { __syncthreads(); s5_item(args, lds, it, false, tid, lane, wave); }
        for (int it = bx; it < 64; it += G) { __syncthreads(); lru_item(args, lds, it, true, tid, lane, wave); }
        for (int it = bx - 64; it < 64; it += G) { if (it < 0) continue; __syncthreads(); s5_item(args, lds, it, true, tid, lane, wave); }
        __syncthreads();
        SEAM(2);
    }
    if (IN(3)) {
        pg8::Gemm g{(const bf16_t*)(ws + WS_V), (const bf16_t*)(ws + WS_W_GLU), MPAD, 4096, 1024, 1024, 1024}; pg8::StaticOrder S; S.init(MPAD, 4096, G, bx);
        pg8::EpiT E{Tb, Zb};
        pg8::gemm_phase<pg8::EpiT, pg8::StaticOrder, true, true>(lds, g, S, E);
        SEAM(3);
    }
    if (IN(4)) {
        pg8::Gemm g{(const bf16_t*)(ws + WS_HS), (const bf16_t*)(ws + WS_W_PROJ), MPAD, DM, DM, DM, DM}; pg8::StaticOrder S; S.init(MPAD, DM, G, bx);
        pg8::EpiMerged E{Tb, Zb};
        pg8::gemm_phase<pg8::EpiMerged, pg8::StaticOrder, true, true>(lds, g, S, E);
        SEAM(4);
    }
    if (IN(5)) {
        pg8::Gemm g{(const bf16_t*)(ws + WS_T), (const bf16_t*)(ws + WS_W_OUT), MPAD, DM, DM, DM, DM}; pg8::StaticOrder S; S.init(MPAD, DM, G, bx);
        pg8::EpiRes<true> E{args.in[0], args.in[1], args.out, (bf16_t*)(ws + WS_X1B), part1};
        pg8::gemm_phase<pg8::EpiRes<true>, pg8::StaticOrder, true, true>(lds, g, S, E);
        SEAM(5);
    }
    if (IN(6)) {
        pg8::Gemm g{(const bf16_t*)(ws + WS_X1B), (const bf16_t*)(ws + WS_W_GU), MPAD, 2 * DFF, DM, DM, DM}; pg8::StaticOrder S; S.init(MPAD, 2 * DFF, G, bx);
        pg8::EpiAct E{(bf16_t*)(ws + WS_ACT), part1};
        pg8::gemm_phase<pg8::EpiAct, pg8::StaticOrder, true, true>(lds, g, S, E);
        SEAM(6);
    }
    if (IN(7)) {
        pg8::Gemm g{(const bf16_t*)(ws + WS_ACT), (const bf16_t*)(ws + WS_W_DN), MPAD, DM, DFF, DFF, DFF}; pg8::StaticOrder S; S.init(MPAD, DM, G, bx);
        pg8::EpiRes<false> E{args.out, args.out + (size_t)MP * DM, args.out, nullptr, part2};
        pg8::gemm_phase<pg8::EpiRes<false>, pg8::StaticOrder, true, true>(lds, g, S, E);
        SEAM(7);
    }
    if (IN(8)) {
        const int gw = vcu * 8 + wave, NGW = G * 8;
        const GAS f32x4* gf = (const GAS f32x4*)args.in[31] + lane;
        for (int m = gw; m < M; m += NGW) {
            float s = lane < 32 ? part2[(size_t)m * 32 + lane] : 0.f; s = wave_sum(s);
            const float r = rsqrtf(s * (1.f / DM) + EPS);
            GAS f32x4* xr = (GAS f32x4*)(args.out + (size_t)m * DM) + lane;
#pragma unroll
            for (int j = 0; j < 8; ++j) { const f32x4 v = xr[64 * j]; xr[64 * j] = v * r * gf[64 * j]; }
        }
    }
#undef IN
#undef SEAM
}

extern "C" void kernel_launch(void* const* d_in, const int* in_sizes, int n_in, void* d_out, int out_size, void* d_ws, size_t ws_size, hipStream_t stream) {
    static int grid = 0;
    if (grid == 0) {
        if (n_in != 32 || out_size != (int)O_END || ws_size < WS_END) { fprintf(stderr, "kernel_launch: unexpected shapes (n_in %d, out %d, ws %zu); nothing launched\n", n_in, out_size, ws_size); grid = -1; return; }
        int dev = 0, cus = 0, per_cu = 0;
        if (hipGetDevice(&dev) != hipSuccess || hipDeviceGetAttribute(&cus, hipDeviceAttributeMultiprocessorCount, dev) != hipSuccess) { grid = -1; return; }
        if (hipFuncSetAttribute((const void*)hyb_fwd, hipFuncAttributeMaxDynamicSharedMemorySize, LDS_BYTES) != hipSuccess) { fprintf(stderr, "kernel_launch: hipFuncSetAttribute failed\n"); grid = -1; return; }
        if (hipOccupancyMaxActiveBlocksPerMultiprocessor(&per_cu, (const void*)hyb_fwd, 512, LDS_BYTES) != hipSuccess || per_cu < 1) { fprintf(stderr, "kernel_launch: occupancy query says %d\n", per_cu); per_cu = 1; }
        (void)hipGetLastError();
        grid = cus;
    }
    if (grid < 0) return;
    (void)hipMemsetAsync((char*)d_ws + WS_CTL, 0, CTL_ZERO_BYTES, stream);
    Args a{};
    for (int i = 0; i < 32; ++i) a.in[i] = (const float*)d_in[i];
    a.out = (float*)d_out; a.ws = (unsigned char*)d_ws;
    if (MK_N_LAUNCHES == 1) { a.ph_lo = 0; a.ph_hi = NPHASE; a.li = 0; hipLaunchKernelGGL(hyb_fwd, dim3(grid), dim3(512), LDS_BYTES, stream, a); }
    else for (int p = 0; p < NPHASE; ++p) { a.ph_lo = p; a.ph_hi = p + 1; a.li = p; hipLaunchKernelGGL(hyb_fwd, dim3(grid), dim3(512), LDS_BYTES, stream, a); }
}
```

```cpp
#include <hip/hip_runtime.h>
#include <cstdio>
#include <cstdint>

#ifndef MK_N_LAUNCHES
#define MK_N_LAUNCHES 1
#endif

#define LAS __attribute__((address_space(3)))
#define GAS __attribute__((address_space(1)))
typedef unsigned short bf16_t;
typedef short bf16x8 __attribute__((ext_vector_type(8)));
typedef float f32x4 __attribute__((ext_vector_type(4)));
typedef float f32x2 __attribute__((ext_vector_type(2)));
typedef unsigned u32x4 __attribute__((ext_vector_type(4)));
typedef unsigned u32x2 __attribute__((ext_vector_type(2)));

constexpr int DM = 2048, SEQ = 2048, NB = 4, NS = 128;
constexpr int MP = NB * SEQ;
constexpr int M = MP + NS;
constexpr int MPAD = 8448;
constexpr int DFF = 5632, INW = 7168;
constexpr float EPS = 1e-6f;
constexpr int NPHASE = 9;

constexpr size_t WS_CTL = 0, CTL_ZERO_BYTES = 131072;
constexpr size_t WS_RS1 = 131072;
constexpr size_t WS_PART1 = 196608;
constexpr size_t WS_PART2 = WS_PART1 + (size_t)MPAD * 32 * 4;
constexpr size_t WS_W_IN = 4u << 20;
constexpr size_t WS_V = WS_W_IN;
constexpr size_t WS_W_PROJ = WS_W_IN + (size_t)INW * DM * 2;
constexpr size_t WS_W_GLU = WS_W_PROJ + (size_t)DM * DM * 2;
constexpr size_t WS_W_OUT = WS_W_GLU + (size_t)4096 * 1024 * 2;
constexpr size_t WS_W_GU = WS_W_OUT + (size_t)DM * DM * 2;
constexpr size_t WS_W_DN = WS_W_GU + (size_t)2 * DFF * DM * 2;
constexpr size_t WS_Z = WS_W_DN + (size_t)DM * DFF * 2;
constexpr size_t WS_ACT = WS_Z;
constexpr size_t WS_XB = WS_Z + (size_t)MPAD * INW * 2;
constexpr size_t WS_T = WS_XB;
constexpr size_t WS_HS = WS_XB + (size_t)MPAD * DM * 2;
constexpr size_t WS_X1B = WS_HS;
constexpr size_t WS_END = WS_HS + (size_t)MPAD * DM * 2;
static_assert(WS_PART2 + (size_t)MPAD * 32 * 4 <= WS_W_IN, "ws map");
static_assert(WS_END <= 329380096ull, "ws map exceeds the guaranteed workspace");
constexpr size_t O_Y = 0, O_CONV_P = (size_t)M * DM, O_H_P = O_CONV_P + 24576, O_SRE_P = O_H_P + 8192, O_SIM_P = O_SRE_P + 16384,
                 O_CONV_S = O_SIM_P + 16384, O_H_S = O_CONV_S + 786432, O_SRE_S = O_H_S + 262144, O_SIM_S = O_SRE_S + 524288, O_END = O_SIM_S + 524288;
static_assert(O_END == 19202048, "d_out map");
constexpr int CW_TMO = 0;
constexpr int CW_BAR = 4096;
constexpr int CW_CNT = 16384;
static_assert((CW_CNT + 4 * 33 * 64) * 4 <= (int)CTL_ZERO_BYTES, "ctl words inside the memset region");

constexpr int RING_BYTES = 131072, LDSCTL_OFF = RING_BYTES, MISC_OFF = LDSCTL_OFF + 320, LDS_BYTES = 147456;

struct Args { const float* in[32]; float* out; unsigned char* ws; int ph_lo, ph_hi, li, pad; };

__device__ __forceinline__ unsigned f2bf(float f) { unsigned u = __builtin_bit_cast(unsigned, f); return (u + 0x7fffu + ((u >> 16) & 1u)) >> 16; }
__device__ __forceinline__ unsigned pk2(float lo, float hi) { return f2bf(lo) | (f2bf(hi) << 16); }
__device__ __forceinline__ unsigned cvt_pk_bf16(float lo, float hi) { unsigned r; asm volatile("v_cvt_pk_bf16_f32 %0, %1, %2" : "=v"(r) : "v"(lo), "v"(hi)); return r; }
__device__ __forceinline__ float bflo(unsigned w) { return __uint_as_float(w << 16); }
__device__ __forceinline__ float bfhi(unsigned w) { return __uint_as_float(w & 0xffff0000u); }
__device__ __forceinline__ float bf2f(unsigned short b) { return __uint_as_float((unsigned)b << 16); }
__device__ __forceinline__ float sigm(float x) { return __builtin_amdgcn_rcpf(1.f + __expf(-x)); }
__device__ __forceinline__ float wave_sum(float v) {
#pragma unroll
    for (int o = 1; o < 64; o <<= 1) v += __shfl_xor(v, o);
    return v;
}
#define LDS_WAIT() asm volatile("s_waitcnt lgkmcnt(0)" ::: "memory")
#define VM_WAIT() asm volatile("s_waitcnt vmcnt(0)" ::: "memory")

namespace pg8 {
constexpr int BM = 256, BK = 64, HALF = 128, HTB = HALF * BK * 2, STAGE_BYTES = 8 * HTB, NXCD = 8, WGM = 8;
__host__ __device__ __forceinline__ int lds_byte(int r, int c) { const int st = (r >> 4) * 2 + (c >> 5), rr = r & 15, cc = c & 31, ob = rr * 64 + cc * 2; return st * 1024 + (ob ^ (((ob >> 9) & 1) << 5)); }
__host__ __device__ __forceinline__ void stage_rc(int b, int& R, int& C) { const int st = b / 1024, sb = b % 1024, swz = sb ^ (((sb >> 9) & 1) << 5); R = (st >> 1) * 16 + swz / 64; C = (st & 1) * 32 + (swz % 64) / 2; }
__host__ __device__ __forceinline__ int perm32(int rho) { const int n = rho >> 4, i = rho & 15; return 8 * (i >> 2) + 4 * n + (i & 3); }

struct Unit { int pm, pn; };
struct Gemm { const bf16_t* A; const bf16_t* Bt; int M, N, K, lda, ldb; };

struct StaticOrder {
    int nM, nN, nwg, G, c;
    __device__ void init(int M_, int N_, int G_, int c_) { nM = M_ / BM; nN = N_ / BM; nwg = nM * nN; G = G_; c = c_; }
    __device__ bool next(int i, Unit& u) const {
        const long L = (long)i * G + c; if (L >= nwg) return false;
        int wgid = (int)L; { const int q = nwg / NXCD, r = nwg % NXCD, xcd = wgid % NXCD, off = wgid / NXCD; wgid = (xcd < r ? xcd * (q + 1) : r * (q + 1) + (xcd - r) * q) + off; }
        const int nig = WGM * nN, gid = wgid / nig, fm = gid * WGM, gsz = (nM - fm) < WGM ? (nM - fm) : WGM;
        u.pm = fm + ((wgid % nig) % gsz); u.pn = (wgid % nig) / gsz; return true;
    }
    __device__ __forceinline__ void a_ready(const Unit&) const {}
    __device__ __forceinline__ void done(const Unit&) const {}
};

template <class Epi, class Sched, bool ALIGN_EPI = false, bool SP2 = false>
__device__ __forceinline__ void gemm_phase(LAS unsigned char* lds, const Gemm g, const Sched& S, const Epi& E) {
    const int tid = threadIdx.x, wid = __builtin_amdgcn_readfirstlane(tid >> 6), lane = tid & 63, wr = wid >> 2, wc = wid & 3, fr = lane & 15, fq = lane >> 4;
    const int K = g.K, nt = K / BK;
    unsigned voffA[2], voffB[2];
#pragma unroll
    for (int i = 0; i < 2; ++i) { int R, C; stage_rc(tid * 16 + i * 8192, R, C); const int Rb = Epi::PERM ? ((R & ~31) + perm32(R & 31)) : R;
        voffA[i] = (unsigned)(R * g.lda + C) * 2u; voffB[i] = (unsigned)(Rb * g.ldb + C) * 2u; }
    const size_t kstep = (size_t)(BK * 2);
    const size_t hstepA = (size_t)HALF * g.lda * 2, hstepB = (size_t)HALF * g.ldb * 2;
    const size_t tstepA = 2 * hstepA, tstepB = 2 * hstepB;
    const unsigned ldsw = (unsigned)wid * 1024u;
    const int aoff = lds_byte(wr * 64 + fr, fq * 8), boff = lds_byte(wc * 32 + fr, fq * 8);
#define PG8_SA(b, h) (((b) * 2 + (h)) * HTB)
#define PG8_SB(b, h) ((4 + (b) * 2 + (h)) * HTB)
#define PG8_STAGE(bufoff, gbase, voff) do { _Pragma("unroll") for (int _i = 0; _i < 2; ++_i) \
        __builtin_amdgcn_global_load_lds((const unsigned*)((const char*)(gbase) + (voff)[_i]), (LAS unsigned*)(lds + (bufoff) + ldsw + _i * 8192), 16, 0, 0); } while (0)
#define PG8_LDA(dst, b, h) do { _Pragma("unroll") for (int m = 0; m < 4; ++m) _Pragma("unroll") for (int k = 0; k < 2; ++k) dst[m][k] = *(const LAS bf16x8*)(lds + PG8_SA(b, h) + aoff + m * 2048 + k * 1024); } while (0)
#define PG8_LDB(dst, b, h) do { _Pragma("unroll") for (int n = 0; n < 2; ++n) _Pragma("unroll") for (int k = 0; k < 2; ++k) dst[n][k] = *(const LAS bf16x8*)(lds + PG8_SB(b, h) + boff + n * 2048 + k * 1024); } while (0)
#define PG8_MMA(ai, bj, At, Bt) do { __builtin_amdgcn_s_setprio(1); _Pragma("unroll") for (int m = 0; m < 4; ++m) _Pragma("unroll") for (int n = 0; n < 2; ++n) _Pragma("unroll") for (int k = 0; k < 2; ++k) \
        acc[ai][bj][m][n] = __builtin_amdgcn_mfma_f32_16x16x32_bf16(Bt[n][k], At[m][k], acc[ai][bj][m][n], 0, 0, 0); __builtin_amdgcn_s_setprio(0); } while (0)
#define PG8_WAIT_V(n) asm volatile("s_waitcnt vmcnt(" #n ")" ::: "memory")
#define PG8_WAIT_L(n) asm volatile("s_waitcnt lgkmcnt(" #n ")" ::: "memory")
#define PG8_BAR __builtin_amdgcn_s_barrier()
#define PG8_SCHED __builtin_amdgcn_sched_barrier(0)
    Unit cur, nxt; int ui = 0;
    if (!S.next(0, cur)) return;
    f32x4 acc[2][2][4][2];
#pragma unroll
    for (int a = 0; a < 2; ++a)
#pragma unroll
        for (int b = 0; b < 2; ++b)
#pragma unroll
            for (int m = 0; m < 4; ++m)
#pragma unroll
                for (int n = 0; n < 2; ++n) acc[a][b][m][n] = (f32x4){0.f, 0.f, 0.f, 0.f};
    bf16x8 At[4][2], B0[2][2], B1[2][2];
    const char* cA = (const char*)g.A + (size_t)cur.pm * tstepA; const char* cB = (const char*)g.Bt + (size_t)cur.pn * tstepB;
    S.a_ready(cur);
    if constexpr (SP2) {
        PG8_STAGE(PG8_SB(0, 0), cB, voffB); PG8_STAGE(PG8_SB(0, 1), cB + hstepB, voffB); PG8_STAGE(PG8_SA(0, 0), cA, voffA); PG8_STAGE(PG8_SA(0, 1), cA + hstepA, voffA);
        if (wr == 1) PG8_BAR;
        PG8_WAIT_V(2); PG8_BAR;
        PG8_STAGE(PG8_SB(1, 0), cB + kstep, voffB); PG8_STAGE(PG8_SA(1, 0), cA + kstep, voffA); PG8_STAGE(PG8_SB(1, 1), cB + hstepB + kstep, voffB);
        PG8_WAIT_V(6); PG8_BAR;
    } else {
        PG8_STAGE(PG8_SB(0, 0), cB, voffB); PG8_STAGE(PG8_SA(0, 0), cA, voffA); PG8_STAGE(PG8_SB(0, 1), cB + hstepB, voffB); PG8_STAGE(PG8_SA(0, 1), cA + hstepA, voffA);
        if (wr == 1) PG8_BAR;
        PG8_WAIT_V(4); PG8_BAR;
        PG8_STAGE(PG8_SB(1, 0), cB + kstep, voffB); PG8_STAGE(PG8_SA(1, 0), cA + kstep, voffA); PG8_STAGE(PG8_SB(1, 1), cB + hstepB + kstep, voffB);
        PG8_WAIT_V(6); PG8_BAR;
    }
    for (;;) {
        const bool has_next = S.next(ui + 1, nxt);
        const char* nA = has_next ? (const char*)g.A + (size_t)nxt.pm * tstepA : cA; const char* nB = has_next ? (const char*)g.Bt + (size_t)nxt.pn * tstepB : cB;
        for (int t = 0; t < nt; t += 2) {
            const bool last = (t == nt - 2);
            const char* a1 = cA + (size_t)(t + 1) * kstep;
            const char* a2 = last ? nA : cA + (size_t)(t + 2) * kstep; const char* b2 = last ? nB : cB + (size_t)(t + 2) * kstep;
            const char* a3 = a2 + kstep; const char* b3 = b2 + kstep;
            if (last && has_next) S.a_ready(nxt);
            if constexpr (SP2) {
            PG8_LDB(B0, 0, 0); PG8_LDB(B1, 0, 1); PG8_SCHED; PG8_LDA(At, 0, 0); PG8_STAGE(PG8_SA(1, 1), a1 + hstepA, voffA);
            PG8_WAIT_V(8); PG8_WAIT_L(0); PG8_BAR; PG8_MMA(0, 0, At, B0); PG8_MMA(0, 1, At, B1); PG8_BAR; PG8_SCHED;
            PG8_LDA(At, 0, 1); PG8_STAGE(PG8_SB(0, 0), b2, voffB); PG8_STAGE(PG8_SB(0, 1), b2 + hstepB, voffB); PG8_STAGE(PG8_SA(0, 0), a2, voffA);
            PG8_WAIT_V(8); PG8_WAIT_L(0); PG8_BAR; PG8_MMA(1, 0, At, B0); PG8_MMA(1, 1, At, B1); PG8_BAR; PG8_SCHED;
            PG8_LDB(B0, 1, 0); PG8_LDB(B1, 1, 1); PG8_SCHED; PG8_LDA(At, 1, 0); PG8_STAGE(PG8_SA(0, 1), a2 + hstepA, voffA);
            PG8_WAIT_V(8); PG8_WAIT_L(0); PG8_BAR; PG8_MMA(0, 0, At, B0); PG8_MMA(0, 1, At, B1); PG8_BAR; PG8_SCHED;
            PG8_LDA(At, 1, 1); PG8_STAGE(PG8_SB(1, 0), b3, voffB); PG8_STAGE(PG8_SB(1, 1), b3 + hstepB, voffB); PG8_STAGE(PG8_SA(1, 0), a3, voffA);
            PG8_WAIT_V(8); PG8_WAIT_L(0); PG8_BAR; PG8_MMA(1, 0, At, B0); PG8_MMA(1, 1, At, B1); PG8_BAR; PG8_SCHED;
            } else {
            PG8_LDB(B0, 0, 0); PG8_SCHED; PG8_LDA(At, 0, 0); PG8_STAGE(PG8_SA(1, 1), a1 + hstepA, voffA);
            PG8_WAIT_L(8); PG8_BAR; PG8_WAIT_L(0); PG8_MMA(0, 0, At, B0); PG8_BAR; PG8_SCHED;
            PG8_LDB(B1, 0, 1); PG8_STAGE(PG8_SB(0, 0), b2, voffB);
            PG8_BAR; PG8_WAIT_L(0); PG8_MMA(0, 1, At, B1); PG8_BAR;
            PG8_LDA(At, 0, 1); PG8_STAGE(PG8_SA(0, 0), a2, voffA);
            PG8_BAR; PG8_WAIT_L(0); PG8_MMA(1, 0, At, B0); PG8_BAR; PG8_SCHED;
            PG8_STAGE(PG8_SB(0, 1), b2 + hstepB, voffB);
            PG8_WAIT_V(6); PG8_BAR; PG8_MMA(1, 1, At, B1); PG8_BAR;
            PG8_LDB(B0, 1, 0); PG8_SCHED; PG8_LDA(At, 1, 0); PG8_STAGE(PG8_SA(0, 1), a2 + hstepA, voffA);
            PG8_WAIT_L(8); PG8_BAR; PG8_WAIT_L(0); PG8_MMA(0, 0, At, B0); PG8_BAR; PG8_SCHED;
            PG8_LDB(B1, 1, 1); PG8_STAGE(PG8_SB(1, 0), b3, voffB);
            PG8_BAR; PG8_WAIT_L(0); PG8_MMA(0, 1, At, B1); PG8_BAR;
            PG8_LDA(At, 1, 1); PG8_STAGE(PG8_SA(1, 0), a3, voffA);
            PG8_BAR; PG8_WAIT_L(0); PG8_MMA(1, 0, At, B0); PG8_BAR; PG8_SCHED;
            PG8_STAGE(PG8_SB(1, 1), b3 + hstepB, voffB);
            PG8_WAIT_V(6); PG8_BAR; PG8_MMA(1, 1, At, B1); PG8_BAR;
            }
        }
        if constexpr (ALIGN_EPI) { if (wr == 0) PG8_BAR; }
        if constexpr (!Epi::AFTER_DRAIN) { E(acc, cur, wr, wc, fr, fq); S.done(cur); }
        if (!has_next) break;
#pragma unroll
        for (int a = 0; a < 2; ++a)
#pragma unroll
            for (int b = 0; b < 2; ++b)
#pragma unroll
                for (int m = 0; m < 4; ++m)
#pragma unroll
                    for (int n = 0; n < 2; ++n) acc[a][b][m][n] = (f32x4){0.f, 0.f, 0.f, 0.f};
        cur = nxt; cA = nA; cB = nB; ++ui;
        if constexpr (ALIGN_EPI) { if (wr == 1) PG8_BAR; }
    }
    PG8_WAIT_V(0);
    if constexpr (!ALIGN_EPI) { if (wr == 0) PG8_BAR; }
    PG8_BAR;
#undef PG8_SA
#undef PG8_SB
#undef PG8_STAGE
#undef PG8_LDA
#undef PG8_LDB
#undef PG8_MMA
#undef PG8_WAIT_V
#undef PG8_WAIT_L
#undef PG8_BAR
#undef PG8_SCHED
}

typedef const f32x4 (&AccRef)[2][2][4][2];
__device__ __forceinline__ u32x4 pack8(f32x4 v0, f32x4 v1) { u32x4 w; w.x = cvt_pk_bf16(v0[0], v0[1]); w.y = cvt_pk_bf16(v0[2], v0[3]); w.z = cvt_pk_bf16(v1[0], v1[1]); w.w = cvt_pk_bf16(v1[2], v1[3]); return w; }
__device__ __forceinline__ void unpack8(u32x4 w, f32x4& v0, f32x4& v1) { v0 = (f32x4){bflo(w.x), bfhi(w.x), bflo(w.y), bfhi(w.y)}; v1 = (f32x4){bflo(w.z), bfhi(w.z), bflo(w.w), bfhi(w.w)}; }
__device__ __forceinline__ f32x4 sig4(f32x4 v) { return (f32x4){sigm(v[0]), sigm(v[1]), sigm(v[2]), sigm(v[3])}; }

struct EpiZ { static constexpr bool PERM = true, AFTER_DRAIN = false;
    bf16_t* Z; const float* rs;
    __device__ __forceinline__ void operator()(AccRef acc, const Unit& u, int wr, int wc, int fr, int fq) const {
        const int row0 = u.pm * BM + wr * 64 + fr, colt = u.pn * BM; const bool gate = colt >= 3072; const int col0 = colt + wc * 32 + 8 * fq;
#pragma unroll
        for (int ai = 0; ai < 2; ++ai)
#pragma unroll
            for (int m = 0; m < 4; ++m) { const int row = row0 + ai * HALF + m * 16; const float r = rs[row]; bf16_t* rowp = Z + (size_t)row * INW + col0;
#pragma unroll
                for (int bj = 0; bj < 2; ++bj) { f32x4 v0 = acc[ai][bj][m][0] * r, v1 = acc[ai][bj][m][1] * r; if (gate) { v0 = sig4(v0); v1 = sig4(v1); }
                    *(u32x4*)(rowp + bj * HALF) = pack8(v0, v1); } }
    }
};
struct EpiT { static constexpr bool PERM = true, AFTER_DRAIN = false;
    bf16_t* T; const bf16_t* Z;
    __device__ __forceinline__ void operator()(AccRef acc, const Unit& u, int wr, int wc, int fr, int fq) const {
        const int row0 = u.pm * BM + wr * 64 + fr, co0 = u.pn * HALF + wc * 32 + 8 * fq;
#pragma unroll
        for (int ai = 0; ai < 2; ++ai)
#pragma unroll
            for (int m = 0; m < 4; ++m) { const int row = row0 + ai * HALF + m * 16;
                f32x4 g0, g1; unpack8(*(const u32x4*)(Z + (size_t)row * INW + 5120 + co0), g0, g1);
                const f32x4 t0 = acc[ai][0][m][0] * sig4(acc[ai][1][m][0]) * g0, t1 = acc[ai][0][m][1] * sig4(acc[ai][1][m][1]) * g1;
                *(u32x4*)(T + (size_t)row * DM + co0) = pack8(t0, t1); }
    }
};
struct EpiMerged { static constexpr bool PERM = true, AFTER_DRAIN = false;
    bf16_t* T; const bf16_t* Z;
    __device__ __forceinline__ void operator()(AccRef acc, const Unit& u, int wr, int wc, int fr, int fq) const {
        const int row0 = u.pm * BM + wr * 64 + fr, col0 = u.pn * BM + wc * 32 + 8 * fq;
#pragma unroll
        for (int ai = 0; ai < 2; ++ai)
#pragma unroll
            for (int m = 0; m < 4; ++m) { const int row = row0 + ai * HALF + m * 16;
#pragma unroll
                for (int bj = 0; bj < 2; ++bj) { const int c = col0 + bj * HALF; f32x4 g0, g1, t0, t1;
                    unpack8(*(const u32x4*)(Z + (size_t)row * INW + 3072 + c), g0, g1); bf16_t* tp = T + (size_t)row * DM + c; unpack8(*(const u32x4*)tp, t0, t1);
                    *(u32x4*)tp = pack8(acc[ai][bj][m][0] * g0 + t0, acc[ai][bj][m][1] * g1 + t1); } }
    }
};
template <bool WITH_BF16> struct EpiRes { static constexpr bool PERM = false, AFTER_DRAIN = false;
    const float* base_p; const float* base_s; float* out; bf16_t* outb; float* part;
    __device__ __forceinline__ void operator()(AccRef acc, const Unit& u, int wr, int wc, int fr, int fq) const {
        const int row0 = u.pm * BM + wr * 64 + fr, col0 = u.pn * BM + wc * 32 + 4 * fq;
#pragma unroll
        for (int ai = 0; ai < 2; ++ai)
#pragma unroll
            for (int m = 0; m < 4; ++m) { const int row = row0 + ai * HALF + m * 16; const bool valid = row < M;
                const float* br = row < MP ? base_p + (size_t)row * DM : base_s + (size_t)(row - MP) * DM; float ss = 0.f;
#pragma unroll
                for (int bj = 0; bj < 2; ++bj)
#pragma unroll
                    for (int n = 0; n < 2; ++n) { const int c = col0 + bj * HALF + n * 16; f32x4 v = acc[ai][bj][m][n];
                        if (valid) { v += *(const f32x4*)(br + c); *(f32x4*)(out + (size_t)row * DM + c) = v; }
                        ss += (v[0] * v[0] + v[1] * v[1]) + (v[2] * v[2] + v[3] * v[3]);
                        if (WITH_BF16) { u32x2 w; w.x = cvt_pk_bf16(v[0], v[1]); w.y = cvt_pk_bf16(v[2], v[3]); *(u32x2*)(outb + (size_t)row * DM + c) = w; } }
                ss += __shfl_xor(ss, 16); ss += __shfl_xor(ss, 32);
                if (fq == 0) part[(size_t)row * 32 + u.pn * 4 + wc] = ss; }
    }
};
struct EpiAct { static constexpr bool PERM = true, AFTER_DRAIN = false;
    bf16_t* ACT; const float* part;
    __device__ __forceinline__ void operator()(AccRef acc, const Unit& u, int wr, int wc, int fr, int fq) const {
        const int row0 = u.pm * BM + wr * 64 + fr, co0 = u.pn * HALF + wc * 32 + 8 * fq;
#pragma unroll
        for (int ai = 0; ai < 2; ++ai)
#pragma unroll
            for (int m = 0; m < 4; ++m) { const int row = row0 + ai * HALF + m * 16;
                const f32x4 p0 = *(const f32x4*)(part + (size_t)row * 32 + 8 * fq), p1 = *(const f32x4*)(part + (size_t)row * 32 + 8 * fq + 4);
                float ss = ((p0[0] + p0[1]) + (p0[2] + p0[3])) + ((p1[0] + p1[1]) + (p1[2] + p1[3])); ss += __shfl_xor(ss, 16); ss += __shfl_xor(ss, 32);
                const float r = rsqrtf(ss * (1.f / DM) + EPS);
                const f32x4 g0 = acc[ai][0][m][0] * r, g1 = acc[ai][0][m][1] * r, u0 = acc[ai][1][m][0] * r, u1 = acc[ai][1][m][1] * r;
                *(u32x4*)(ACT + (size_t)row * DFF + co0) = pack8(g0 * sig4(g0) * u0, g1 * sig4(g1) * u1); }
    }
};
}

#define XB_TMO      128
#define XB_XCNT(j)  (256  + 64 * (j))
#define XB_XSUB(j)  (1280 + 64 * (j))
#define XB_XGEN(j)  (2304 + 64 * (j))
#define XB_TOP      3328
#define XB_TOPGEN   3392
#define XCD_BAR_WORDS 3456
#define XB_SPIN_CAP (1u << 22)
__device__ __forceinline__ unsigned xb_ld(unsigned* p)              { return __hip_atomic_load(p, __ATOMIC_RELAXED, __HIP_MEMORY_SCOPE_AGENT); }
__device__ __forceinline__ unsigned xb_add(unsigned* p, unsigned v) { return __hip_atomic_fetch_add(p, v, __ATOMIC_RELAXED, __HIP_MEMORY_SCOPE_AGENT); }
__device__ __forceinline__ unsigned xb_xcc_id() { return (unsigned)__builtin_amdgcn_s_getreg((3 << 11) | 20) & 0xFu; }
#define XB_SPIN(cond, bar) do { unsigned _sp = 0; while (cond) { __builtin_amdgcn_s_sleep(1); \
    if ((++_sp & 255u) == 0u) { if (xb_ld(&(bar)[XB_TMO])) break; if (_sp > XB_SPIN_CAP) { atomicAdd(&(bar)[XB_TMO], 1u); break; } } } } while (0)
struct XcdBarrier { unsigned* bar; unsigned x; volatile LAS unsigned* st; };
__device__ __forceinline__ XcdBarrier xcd_barrier_post(unsigned* bar, volatile LAS unsigned* st) {
    XcdBarrier b; b.bar = bar; b.x = xb_xcc_id(); b.st = st;
    if (threadIdx.x == 0) (void)xb_add(&bar[XB_XCNT(b.x)], 1u);
    return b;
}
__device__ __forceinline__ void xcd_barrier_complete(unsigned* bar, unsigned x, unsigned& nloc, unsigned& nx) {
    const unsigned G = gridDim.x * gridDim.y * gridDim.z;
    unsigned sum, cnt, mine, sp = 0u;
    for (;;) {
        sum = 0u; cnt = 0u; mine = 0u;
#pragma unroll
        for (unsigned j = 0; j < 16; ++j) { const unsigned c = xb_ld(&bar[XB_XCNT(j)]); sum += c; cnt += (c > 0u) ? 1u : 0u; mine = (j == x) ? c : mine; }
        if (sum == G) break;
        __builtin_amdgcn_s_sleep(1);
        if ((++sp & 255u) == 0u) { if (xb_ld(&bar[XB_TMO])) break; if (sp > XB_SPIN_CAP) { atomicAdd(&bar[XB_TMO], 1u); break; } }
    }
    nloc = mine > 0u ? mine : 1u; nx = cnt > 0u ? cnt : 1u;
}
__device__ __forceinline__ void xcd_barrier(const XcdBarrier& b) {
    asm volatile("s_waitcnt vmcnt(0)" ::: "memory");
    __syncthreads();
    if (threadIdx.x == 0) {
        unsigned* bar = b.bar;
        __builtin_amdgcn_s_waitcnt(0);
        unsigned nloc = b.st[0], nx = b.st[1];
        if (nloc == 0u) { xcd_barrier_complete(bar, b.x, nloc, nx); b.st[0] = nloc; b.st[1] = nx; }
        const unsigned old = xb_add(&bar[XB_XSUB(b.x)], 1u);
        const unsigned gen = old / nloc;
        if (old + 1u == (gen + 1u) * nloc) {
            __builtin_amdgcn_fence(__ATOMIC_RELEASE, "agent");
            asm volatile("s_waitcnt vmcnt(0)" ::: "memory");
            const unsigned og = xb_add(&bar[XB_TOP], 1u);
            const unsigned tg = og / nx;
            if (og + 1u == (tg + 1u) * nx) xb_add(&bar[XB_TOPGEN], 1u);
            else XB_SPIN(xb_ld(&bar[XB_TOPGEN]) == tg, bar);
            __builtin_amdgcn_fence(__ATOMIC_ACQUIRE, "agent");
            xb_add(&bar[XB_XGEN(b.x)], 1u);
            asm volatile("s_waitcnt vmcnt(0)" ::: "memory");
        } else {
            XB_SPIN(xb_ld(&bar[XB_XGEN(b.x)]) == gen, bar);
            __builtin_amdgcn_fence(__ATOMIC_ACQUIRE, "agent");
            asm volatile("s_waitcnt vmcnt(0)" ::: "memory");
        }
    }
    __syncthreads();
}

__device__ __forceinline__ void p0_transpose_item(const float* W, int K, int N, const float* gs, bf16_t* WT, int mode, int which, LAS float* scr, int item, int lane) {
    const int nblk = N / 64, kb = item / nblk, nb = item % nblk, k0 = 64 * kb, n0 = 64 * nb;
    const int lr = lane >> 4, lc4 = (lane & 15) * 4;
    f32x4 v[16];
#pragma unroll
    for (int i = 0; i < 16; ++i) v[i] = *(const GAS f32x4*)(W + (size_t)(k0 + 4 * i + lr) * N + n0 + lc4);
    if (gs) {
#pragma unroll
        for (int i = 0; i < 16; ++i) v[i] = v[i] * gs[k0 + 4 * i + lr];
    }
#pragma unroll
    for (int i = 0; i < 16; ++i) { const int k = 4 * i + lr; *(LAS f32x4*)(scr + k * 64 + (lc4 ^ (((k >> 3) & 7) << 3))) = v[i]; }
    LDS_WAIT(); asm volatile("" ::: "memory");
    const int c = lane & 7;
#pragma unroll
    for (int j = 0; j < 8; ++j) { const int n = (lane >> 3) + 8 * j; const LAS float* s = scr + (8 * c) * 64 + (n ^ (c << 3));
        u32x4 o; o.x = pk2(s[0 * 64], s[1 * 64]); o.y = pk2(s[2 * 64], s[3 * 64]); o.z = pk2(s[4 * 64], s[5 * 64]); o.w = pk2(s[6 * 64], s[7 * 64]);
        const int gn = n0 + n; const int drow = mode ? ((gn >> 7) * 256 + which * 128 + (gn & 127)) : gn;
        *(GAS u32x4*)(WT + (size_t)drow * K + k0 + 8 * c) = o; }
    LDS_WAIT(); asm volatile("" ::: "memory");
}
__device__ __forceinline__ void p0_prologue(const Args& A, LAS unsigned char* lds, int vcu, int G, int wave, int lane) {
    LAS float* scr = (LAS float*)(lds + wave * 16384);
    const int gw = vcu * 8 + wave, NGW = G * 8;
    unsigned char* ws = A.ws;
    constexpr int I_IN = (DM / 64) * (INW / 64), I_SQ = (DM / 64) * (DM / 64), I_GLU = (1024 / 64) * (DM / 64), I_FF = (DM / 64) * (DFF / 64), I_DN = (DFF / 64) * (DM / 64);
    constexpr int NITEMS = I_IN + 2 * I_SQ + 2 * I_GLU + 2 * I_FF + I_DN;
    for (int it = gw; it < NITEMS; it += NGW) {
        int r = it;
        if (r < I_IN) { p0_transpose_item(A.in[7], DM, INW, A.in[6], (bf16_t*)(ws + WS_W_IN), 0, 0, scr, r, lane); continue; } r -= I_IN;
        if (r < I_FF) { p0_transpose_item(A.in[28], DM, DFF, A.in[27], (bf16_t*)(ws + WS_W_GU), 1, 0, scr, r, lane); continue; } r -= I_FF;
        if (r < I_FF) { p0_transpose_item(A.in[29], DM, DFF, A.in[27], (bf16_t*)(ws + WS_W_GU), 1, 1, scr, r, lane); continue; } r -= I_FF;
        if (r < I_DN) { p0_transpose_item(A.in[30], DFF, DM, nullptr, (bf16_t*)(ws + WS_W_DN), 0, 0, scr, r, lane); continue; } r -= I_DN;
        if (r < I_SQ) { p0_transpose_item(A.in[15], DM, DM, nullptr, (bf16_t*)(ws + WS_W_PROJ), 0, 0, scr, r, lane); continue; } r -= I_SQ;
        if (r < I_SQ) { p0_transpose_item(A.in[26], DM, DM, nullptr, (bf16_t*)(ws + WS_W_OUT), 0, 0, scr, r, lane); continue; } r -= I_SQ;
        if (r < I_GLU) { p0_transpose_item(A.in[24], 1024, DM, nullptr, (bf16_t*)(ws + WS_W_GLU), 1, 0, scr, r, lane); continue; } r -= I_GLU;
        p0_transpose_item(A.in[25], 1024, DM, nullptr, (bf16_t*)(ws + WS_W_GLU), 1, 1, scr, r, lane);
    }
    bf16_t* XB = (bf16_t*)(ws + WS_XB); float* rs1 = (float*)(ws + WS_RS1);
    for (int m = gw; m < M; m += NGW) {
        const float* xrow = m < MP ? A.in[0] + (size_t)m * DM : A.in[1] + (size_t)(m - MP) * DM;
        const GAS f32x4* xr = (const GAS f32x4*)xrow + lane;
        f32x4 v[8]; float s = 0.f;
#pragma unroll
        for (int j = 0; j < 8; ++j) { v[j] = xr[64 * j]; s += (v[j][0] * v[j][0] + v[j][1] * v[j][1]) + (v[j][2] * v[j][2] + v[j][3] * v[j][3]); }
        s = wave_sum(s);
        GAS u32x2* o8 = (GAS u32x2*)(XB + (size_t)m * DM) + lane;
#pragma unroll
        for (int j = 0; j < 8; ++j) { u32x2 w; w.x = pk2(v[j][0], v[j][1]); w.y = pk2(v[j][2], v[j][3]); o8[64 * j] = w; }
        if (lane == 0) rs1[m] = rsqrtf(s * (1.f / DM) + EPS);
    }
}

__device__ __forceinline__ void lru_item(const Args& A, LAS unsigned char* lds, int item, bool sample, int tid, int lane, int w) {
    int b, h, s;
    if (!sample) { b = item >> 6; h = (item >> 3) & 7; s = item & 7; } else { b = 0; h = item >> 3; s = item & 7; }
    const int c0h = s * 32, c0 = h * 256 + c0h;
    LAS unsigned char* XA = lds;
    LAS float* XF = (LAS float*)(lds + 65536);
    LAS float* PRE = (LAS float*)(lds + 81920);
    LAS float* SEG = (LAS float*)(lds + 116736);
    LAS unsigned short* HSL = (LAS unsigned short*)(lds + 120832);
    const bf16_t* Z = (const bf16_t*)(A.ws + WS_Z);
    bf16_t* HS = (bf16_t*)(A.ws + WS_HS);
    const int nf = w & 3, mh = w >> 2, l15 = lane & 15, l4 = lane >> 4;
    bf16x8 Bf[8];
    {
        const float* Wsrc = ((nf < 2) ? A.in[10] : A.in[12]) + (size_t)h * 65536 + c0h + 16 * (nf & 1) + l15;
#pragma unroll
        for (int ks = 0; ks < 8; ++ks) { const float* p = Wsrc + (size_t)(32 * ks + 8 * l4) * 256;
            u32x4 t; t.x = pk2(p[0], p[256]); t.y = pk2(p[512], p[768]); t.z = pk2(p[1024], p[1280]); t.w = pk2(p[1536], p[1792]); Bf[ks] = __builtin_bit_cast(bf16x8, t); }
    }
    const float pbias = ((nf < 2) ? A.in[11] : A.in[13])[h * 256 + c0h + 16 * (nf & 1) + l15];
    const int sc = tid & 31, sg = tid >> 5;
    const float sp = log1pf(expf(-A.in[14][c0 + sc]));
    const int cg = tid & 31, rg = tid >> 5, gch = h * 256 + cg * 8;
    float cw[4][8], cb[8];
#pragma unroll
    for (int e = 0; e < 8; ++e) { cb[e] = A.in[9][gch + e];
#pragma unroll
        for (int k = 0; k < 4; ++k) cw[k][e] = A.in[8][k * 2048 + gch + e]; }
    const bool insl = (cg >> 2) == s;
    float carry = 0.f;
    const int nch = sample ? 1 : 16;
    for (int ch = 0; ch < nch; ++ch) {
        const int t0 = ch * 128; const int grow0 = sample ? MP : b * SEQ + t0;
        if (!sample) {
            u32x4 raw[11];
#pragma unroll
            for (int jj = 0; jj < 11; ++jj) { const int t = t0 + rg * 8 - 3 + jj; raw[jj] = (u32x4){0u, 0u, 0u, 0u}; if (t >= 0) raw[jj] = *(const u32x4*)(Z + (size_t)(b * SEQ + t) * INW + gch); }
#pragma unroll
            for (int j = 0; j < 8; ++j) {
                float xc[8];
#pragma unroll
                for (int e = 0; e < 8; ++e) xc[e] = cb[e];
#pragma unroll
                for (int k = 0; k < 4; ++k) { f32x4 a0, a1; pg8::unpack8(raw[j + k], a0, a1);
#pragma unroll
                    for (int e = 0; e < 4; ++e) { xc[e] += cw[k][e] * a0[e]; xc[4 + e] += cw[k][4 + e] * a1[e]; } }
                const int row = rg * 8 + j;
                u32x4 o; o.x = pk2(xc[0], xc[1]); o.y = pk2(xc[2], xc[3]); o.z = pk2(xc[4], xc[5]); o.w = pk2(xc[6], xc[7]);
                *(LAS u32x4*)(XA + row * 512 + ((cg ^ (row & 15)) << 4)) = o;
                if (insl) { LAS f32x4* xf = (LAS f32x4*)(XF + row * 32 + (cg & 3) * 8); xf[0] = (f32x4){xc[0], xc[1], xc[2], xc[3]}; xf[1] = (f32x4){xc[4], xc[5], xc[6], xc[7]}; }
            }
            if (ch == 15 && rg == 15 && insl) {
#pragma unroll
                for (int k = 0; k < 3; ++k) { f32x4 a0, a1; pg8::unpack8(raw[8 + k], a0, a1); float* o = A.out + O_CONV_P + (size_t)(b * 3 + k) * 2048 + gch; *(f32x4*)o = a0; *(f32x4*)(o + 4) = a1; }
            }
        } else {
#pragma unroll 2
            for (int j = 0; j < 8; ++j) {
                const int row = rg * 8 + j;
                f32x4 x0, x1; pg8::unpack8(*(const u32x4*)(Z + (size_t)(MP + row) * INW + gch), x0, x1);
                f32x4 bq[3][2];
#pragma unroll
                for (int k = 0; k < 3; ++k) { const float* p = A.in[2] + (size_t)(row * 3 + k) * 2048 + gch; bq[k][0] = *(const f32x4*)p; bq[k][1] = *(const f32x4*)(p + 4); }
                float xc[8];
#pragma unroll
                for (int e = 0; e < 4; ++e) {
                    xc[e] = cb[e] + cw[0][e] * bq[0][0][e] + cw[1][e] * bq[1][0][e] + cw[2][e] * bq[2][0][e] + cw[3][e] * x0[e];
                    xc[4 + e] = cb[4 + e] + cw[0][4 + e] * bq[0][1][e] + cw[1][4 + e] * bq[1][1][e] + cw[2][4 + e] * bq[2][1][e] + cw[3][4 + e] * x1[e]; }
                u32x4 o; o.x = pk2(xc[0], xc[1]); o.y = pk2(xc[2], xc[3]); o.z = pk2(xc[4], xc[5]); o.w = pk2(xc[6], xc[7]);
                *(LAS u32x4*)(XA + row * 512 + ((cg ^ (row & 15)) << 4)) = o;
                if (insl) { LAS f32x4* xf = (LAS f32x4*)(XF + row * 32 + (cg & 3) * 8); xf[0] = (f32x4){xc[0], xc[1], xc[2], xc[3]}; xf[1] = (f32x4){xc[4], xc[5], xc[6], xc[7]};
                    float* o0 = A.out + O_CONV_S + (size_t)(row * 3) * 2048 + gch;
                    *(f32x4*)o0 = bq[1][0]; *(f32x4*)(o0 + 4) = bq[1][1]; *(f32x4*)(o0 + 2048) = bq[2][0]; *(f32x4*)(o0 + 2052) = bq[2][1]; *(f32x4*)(o0 + 4096) = x0; *(f32x4*)(o0 + 4100) = x1; }
            }
        }
        __syncthreads();
#pragma unroll
        for (int mf = 0; mf < 4; ++mf) {
            const int R0 = 64 * mh + 16 * mf; f32x4 acc = (f32x4){0.f, 0.f, 0.f, 0.f};
            const int row = R0 + l15;
#pragma unroll
            for (int ks = 0; ks < 8; ++ks) { const bf16x8 Af = *(const LAS bf16x8*)(XA + row * 512 + (((ks * 4 + l4) ^ (row & 15)) << 4));
                acc = __builtin_amdgcn_mfma_f32_16x16x32_bf16(Af, Bf[ks], acc, 0, 0, 0); }
#pragma unroll
            for (int r = 0; r < 4; ++r) PRE[(R0 + l4 * 4 + r) * 68 + nf * 16 + l15] = acc[r] + pbias;
        }
        __syncthreads();
        float hrun = 0.f, prun = 1.f;
#pragma unroll 2
        for (int j = 0; j < 8; ++j) {
            const int row = sg * 8 + j;
            const float r = sigm(PRE[row * 68 + sc]), ig = sigm(PRE[row * 68 + 32 + sc]), xcv = XF[row * 32 + sc];
            const float la = -8.f * r * sp; const float a = expf(la);
            float mult = sqrtf(-expm1f(2.f * la));
            if (!sample && ch == 0 && row == 0) mult = 1.f;
            const float bt = mult * ig * xcv;
            if (!sample) { hrun = a * hrun + bt; prun *= a; PRE[row * 68 + sc] = hrun; PRE[row * 68 + 32 + sc] = prun; }
            else { const float h0 = A.in[3][(size_t)row * 2048 + c0 + sc]; const float hv = a * h0 + bt; PRE[row * 68 + sc] = hv; PRE[row * 68 + 32 + sc] = 0.f;
                   A.out[O_H_S + (size_t)row * 2048 + c0 + sc] = hv; }
        }
        float mycin = 0.f;
        if (!sample) {
            SEG[(sg * 32 + sc) * 2] = prun; SEG[(sg * 32 + sc) * 2 + 1] = hrun;
            __syncthreads();
            float cin = carry;
#pragma unroll
            for (int jj = 0; jj < 16; ++jj) { if (jj == sg) mycin = cin; cin = SEG[(jj * 32 + sc) * 2] * cin + SEG[(jj * 32 + sc) * 2 + 1]; }
            carry = cin;
        }
#pragma unroll
        for (int j = 0; j < 8; ++j) { const int row = sg * 8 + j; const float hv = PRE[row * 68 + sc] + PRE[row * 68 + 32 + sc] * mycin; HSL[row * 32 + sc] = (unsigned short)f2bf(hv); }
        __syncthreads();
        { const int row = tid >> 2, q = tid & 3; const u32x4 v = *(const LAS u32x4*)(HSL + row * 32 + q * 8); *(u32x4*)(HS + (size_t)(grow0 + row) * DM + c0 + q * 8) = v; }
        if (!sample && ch == 15 && sg == 0) A.out[O_H_P + (size_t)b * 2048 + c0 + sc] = carry;
    }
}

__device__ __forceinline__ float gelu_tanh(float x) {
    const float u = 0.7978845608028654f * (x + 0.044715f * x * x * x);
    const float t = 1.f - 2.f * __builtin_amdgcn_rcpf(1.f + __expf(2.f * u));
    return 0.5f * x * (1.f + t);
}
__device__ __forceinline__ void s5_item(const Args& A, LAS unsigned char* lds, int item, bool sample, int tid, int lane, int w) {
    int b, g; if (!sample) { b = item >> 6; g = item & 63; } else { b = 0; g = item; }
    LAS float* BU = (LAS float*)lds;
    LAS unsigned short* XBL = (LAS unsigned short*)lds;
    LAS unsigned short* BB = (LAS unsigned short*)(lds + 67584);
    LAS float* SEGX = (LAS float*)(lds + 71680);
    const bf16_t* Z = (const bf16_t*)(A.ws + WS_Z);
    bf16_t* V = (bf16_t*)(A.ws + WS_V);
    const int l15 = lane & 15, l4 = lane >> 4;
    const float dt = expf(A.in[18][g]);
    float ar, ai;
    { const float lre = A.in[16][g * 64 + lane], lim = A.in[17][g * 64 + lane]; const float mag = expf(lre * dt); float sn, cs; sincosf(lim * dt, &sn, &cs); ar = mag * cs; ai = mag * sn; }
    float a16r, a16i;
    { float r = ar, i = ai;
#pragma unroll
      for (int q = 0; q < 4; ++q) { const float nr = r * r - i * i, ni = 2.f * r * i; r = nr; i = ni; }
      a16r = r; a16i = i; }
    {
        const int n = tid >> 2, p = n & 63, im = n >> 6;
        const float lre = A.in[16][g * 64 + p], lim = A.in[17][g * 64 + p]; const float mag = expf(lre * dt); float sn, cs; sincosf(lim * dt, &sn, &cs);
        const float e_re = mag * cs - 1.f, e_im = mag * sn, den = lre * lre + lim * lim;
        const float co_re = (e_re * lre + e_im * lim) / den, co_im = (e_im * lre - e_re * lim) / den;
#pragma unroll
        for (int q = 0; q < 4; ++q) { const int hh = (tid & 3) * 4 + q; const float br = A.in[19][(size_t)(g * 64 + p) * 16 + hh], bi = A.in[20][(size_t)(g * 64 + p) * 16 + hh];
            BB[n * 16 + hh] = (unsigned short)f2bf(im ? (co_re * bi + co_im * br) : (co_re * br - co_im * bi)); }
    }
    __syncthreads();
    bf16x8 Bf[8], Cf[4];
    const bf16x8 zero8 = (bf16x8){0, 0, 0, 0, 0, 0, 0, 0};
#pragma unroll
    for (int nfi = 0; nfi < 8; ++nfi) { Bf[nfi] = zero8; if (l4 < 2) Bf[nfi] = *(const LAS bf16x8*)(BB + (16 * nfi + l15) * 16 + 8 * l4); }
#pragma unroll
    for (int ks = 0; ks < 4; ++ks) { const float* src = (ks < 2 ? A.in[21] : A.in[22]) + (size_t)(g * 16 + l15) * 64 + 32 * (ks & 1) + 8 * l4; const float sgn = ks < 2 ? 1.f : -1.f;
        u32x4 t; t.x = pk2(sgn * src[0], sgn * src[1]); t.y = pk2(sgn * src[2], sgn * src[3]); t.z = pk2(sgn * src[4], sgn * src[5]); t.w = pk2(sgn * src[6], sgn * src[7]); Cf[ks] = __builtin_bit_cast(bf16x8, t); }
    const float dv = A.in[23][g * 16 + l15];
    float cr = 0.f, ci = 0.f;
    const int nch = sample ? 1 : 16;
    for (int ch = 0; ch < nch; ++ch) {
        const int grow0 = sample ? MP : b * SEQ + ch * 128;
        bf16x8 Af = zero8; if (l4 < 2) Af = *(const bf16x8*)(Z + (size_t)(grow0 + 16 * w + l15) * INW + 2048 + 16 * g + 8 * l4);
#pragma unroll
        for (int nfi = 0; nfi < 8; ++nfi) { const f32x4 acc = __builtin_amdgcn_mfma_f32_16x16x32_bf16(Af, Bf[nfi], (f32x4){0.f, 0.f, 0.f, 0.f}, 0, 0, 0);
#pragma unroll
            for (int r = 0; r < 4; ++r) BU[(16 * w + l4 * 4 + r) * 132 + 16 * nfi + l15] = acc[r]; }
        LDS_WAIT();
        float xlr[16], xli[16];
        if (!sample) {
            float xr = 0.f, xi = 0.f;
#pragma unroll
            for (int j = 0; j < 16; ++j) { const float br = BU[(16 * w + j) * 132 + lane], bi = BU[(16 * w + j) * 132 + 64 + lane];
                const float nr = ar * xr - ai * xi + br, ni = ar * xi + ai * xr + bi; xr = nr; xi = ni; xlr[j] = xr; xli[j] = xi; }
            SEGX[(w * 64 + lane) * 2] = xr; SEGX[(w * 64 + lane) * 2 + 1] = xi;
            __syncthreads();
            float mr = 0.f, mi = 0.f, c_r = cr, c_i = ci;
#pragma unroll
            for (int jj = 0; jj < 8; ++jj) { if (jj == w) { mr = c_r; mi = c_i; } const float sr = SEGX[(jj * 64 + lane) * 2], si = SEGX[(jj * 64 + lane) * 2 + 1];
                const float nr = a16r * c_r - a16i * c_i + sr, ni = a16r * c_i + a16i * c_r + si; c_r = nr; c_i = ni; }
            cr = c_r; ci = c_i;
            float pr = ar, pi = ai;
#pragma unroll
            for (int j = 0; j < 16; ++j) { const float xr2 = xlr[j] + pr * mr - pi * mi, xi2 = xli[j] + pr * mi + pi * mr; const float npr = pr * ar - pi * ai, npi = pr * ai + pi * ar; pr = npr; pi = npi;
                XBL[(16 * w + j) * 264 + lane] = (unsigned short)f2bf(xr2); XBL[(16 * w + j) * 264 + 64 + lane] = (unsigned short)f2bf(xi2); }
        } else {
#pragma unroll
            for (int j = 0; j < 16; ++j) { const int i = 16 * w + j; const float br = BU[i * 132 + lane], bi = BU[i * 132 + 64 + lane];
                const size_t so = ((size_t)i * 64 + g) * 64 + lane; const float x0r = A.in[4][so], x0i = A.in[5][so];
                xlr[j] = ar * x0r - ai * x0i + br; xli[j] = ar * x0i + ai * x0r + bi; A.out[O_SRE_S + so] = xlr[j]; A.out[O_SIM_S + so] = xli[j]; }
#pragma unroll
            for (int j = 0; j < 16; ++j) { XBL[(16 * w + j) * 264 + lane] = (unsigned short)f2bf(xlr[j]); XBL[(16 * w + j) * 264 + 64 + lane] = (unsigned short)f2bf(xli[j]); }
        }
        LDS_WAIT();
        f32x4 ya = (f32x4){0.f, 0.f, 0.f, 0.f};
#pragma unroll
        for (int ks = 0; ks < 4; ++ks) { const bf16x8 Ax = *(const LAS bf16x8*)(XBL + (16 * w + l15) * 264 + 32 * ks + 8 * l4); ya = __builtin_amdgcn_mfma_f32_16x16x32_bf16(Ax, Cf[ks], ya, 0, 0, 0); }
#pragma unroll
        for (int r = 0; r < 4; ++r) { const size_t grow = (size_t)(grow0 + 16 * w + l4 * 4 + r); const float uu = bf2f(Z[grow * INW + 2048 + 16 * g + l15]);
            V[grow * 1024 + 16 * g + l15] = (bf16_t)f2bf(gelu_tanh(ya[r] + dv * uu)); }
        __syncthreads();
    }
    if (!sample && w == 0) { A.out[O_SRE_P + (size_t)(b * 64 + g) * 64 + lane] = cr; A.out[O_SIM_P + (size_t)(b * 64 + g) * 64 + lane] = ci; }
}

__global__ void __launch_bounds__(512, 2) hyb_fwd(Args args) {
    extern __shared__ __attribute__((aligned(16))) unsigned char lds_raw[];
    LAS unsigned char* lds = (LAS unsigned char*)lds_raw;
    volatile LAS unsigned* MISC = (volatile LAS unsigned*)(lds + MISC_OFF);
    const int tid = threadIdx.x, lane = tid & 63, wave = __builtin_amdgcn_readfirstlane(tid >> 6);
    const int G = gridDim.x, bx = blockIdx.x;
    const int vcu = (G % 8 == 0) ? (bx % 8) * (G / 8) + bx / 8 : bx;
    unsigned char* ws = args.ws;
    for (int u = tid; u < (LDS_BYTES - LDSCTL_OFF) / 4; u += 512) ((LAS unsigned*)(lds + LDSCTL_OFF))[u] = 0u;
    __syncthreads();
    XcdBarrier bar; bar.bar = (unsigned*)(ws + WS_CTL) + CW_BAR; bar.x = 0; bar.st = nullptr;
    if (MK_N_LAUNCHES == 1) bar = xcd_barrier_post((unsigned*)(ws + WS_CTL) + CW_BAR, MISC + 8);
    const int lo = args.ph_lo, hi = args.ph_hi;
#define IN(k) (lo <= (k) && (k) < hi)
#define SEAM(k) do { if (IN(k) && IN((k) + 1)) xcd_barrier(bar); } while (0)
    bf16_t* Zb = (bf16_t*)(ws + WS_Z); bf16_t* Tb = (bf16_t*)(ws + WS_T);
    float* part1 = (float*)(ws + WS_PART1); float* part2 = (float*)(ws + WS_PART2);

    if (IN(0)) { p0_prologue(args, lds, vcu, G, wave, lane); SEAM(0); }
    if (IN(1)) {
        pg8::Gemm g{(const bf16_t*)(ws + WS_XB), (const bf16_t*)(ws + WS_W_IN), MPAD, INW, DM, DM, DM}; pg8::StaticOrder S; S.init(MPAD, INW, G, bx);
        pg8::EpiZ E{Zb, (const float*)(ws + WS_RS1)};
        pg8::gemm_phase<pg8::EpiZ, pg8::StaticOrder, true, true>(lds, g, S, E);
        SEAM(1);
    }
    if (IN(2)) {
        for (int it = bx; it < 256; it += G) { __syncthreads(); lru_item(args, lds, it, false, tid, lane, wave); }
        for (int it = bx; it < 256; it += G) { __syncthreads(); s5_item(args, lds, it, false, tid, lane, wave); }
        for (int it = bx; it < 64; it += G) { __syncthreads(); lru_item(args, lds, it, true, tid, lane, wave); }
        for (int it = bx - 64; it < 64; it += G) { if (it < 0) continue; __syncthreads(); s5_item(args, lds, it, true, tid, lane, wave); }
        __syncthreads();
        SEAM(2);
    }
    if (IN(3)) {
        pg8::Gemm g{(const bf16_t*)(ws + WS_V), (const bf16_t*)(ws + WS_W_GLU), MPAD, 4096, 1024, 1024, 1024}; pg8::StaticOrder S; S.init(MPAD, 4096, G, bx);
        pg8::EpiT E{Tb, Zb};
        pg8::gemm_phase<pg8::EpiT, pg8::StaticOrder, true, true>(lds, g, S, E);
        SEAM(3);
    }
    if (IN(4)) {
        pg8::Gemm g{(const bf16_t*)(ws + WS_HS), (const bf16_t*)(ws + WS_W_PROJ), MPAD, DM, DM, DM, DM}; pg8::StaticOrder S; S.init(MPAD, DM, G, bx);
        pg8::EpiMerged E{Tb, Zb};
        pg8::gemm_phase<pg8::EpiMerged, pg8::StaticOrder, true, true>(lds, g, S, E);
        SEAM(4);
    }
    if (IN(5)) {
        pg8::Gemm g{(const bf16_t*)(ws + WS_T), (const bf16_t*)(ws + WS_W_OUT), MPAD, DM, DM, DM, DM}; pg8::StaticOrder S; S.init(MPAD, DM, G, bx);
        pg8::EpiRes<true> E{args.in[0], args.in[1], args.out, (bf16_t*)(ws + WS_X1B), part1};
        pg8::gemm_phase<pg8::EpiRes<true>, pg8::StaticOrder, true, true>(lds, g, S, E);
        SEAM(5);
    }
    if (IN(6)) {
        pg8::Gemm g{(const bf16_t*)(ws + WS_X1B), (const bf16_t*)(ws + WS_W_GU), MPAD, 2 * DFF, DM, DM, DM}; pg8::StaticOrder S; S.init(MPAD, 2 * DFF, G, bx);
        pg8::EpiAct E{(bf16_t*)(ws + WS_ACT), part1};
        pg8::gemm_phase<pg8::EpiAct, pg8::StaticOrder, true, true>(lds, g, S, E);
        SEAM(6);
    }
    if (IN(7)) {
        pg8::Gemm g{(const bf16_t*)(ws + WS_ACT), (const bf16_t*)(ws + WS_W_DN), MPAD, DM, DFF, DFF, DFF}; pg8::StaticOrder S; S.init(MPAD, DM, G, bx);
        pg8::EpiRes<false> E{args.out, args.out + (size_t)MP * DM, args.out, nullptr, part2};
        pg8::gemm_phase<pg8::EpiRes<false>, pg8::StaticOrder, true, true>(lds, g, S, E);
        SEAM(7);
    }
    if (IN(8)) {
        const int gw = vcu * 8 + wave, NGW = G * 8;
        const GAS f32x4* gf = (const GAS f32x4*)args.in[31] + lane;
        for (int m = gw; m < M; m += NGW) {
            float s = lane < 32 ? part2[(size_t)m * 32 + lane] : 0.f; s = wave_sum(s);
            const float r = rsqrtf(s * (1.f / DM) + EPS);
            GAS f32x4* xr = (GAS f32x4*)(args.out + (size_t)m * DM) + lane;
#pragma unroll
            for (int j = 0; j < 8; ++j) { const f32x4 v = xr[64 * j]; xr[64 * j] = v * r * gf[64 * j]; }
        }
    }
#undef IN
#undef SEAM
}

extern "C" void kernel_launch(void* const* d_in, const int* in_sizes, int n_in, void* d_out, int out_size, void* d_ws, size_t ws_size, hipStream_t stream) {
    static int grid = 0;
    if (grid == 0) {
        if (n_in != 32 || out_size != (int)O_END || ws_size < WS_END) { fprintf(stderr, "kernel_launch: unexpected shapes (n_in %d, out %d, ws %zu); nothing launched\n", n_in, out_size, ws_size); grid = -1; return; }
        int dev = 0, cus = 0, per_cu = 0;
        if (hipGetDevice(&dev) != hipSuccess || hipDeviceGetAttribute(&cus, hipDeviceAttributeMultiprocessorCount, dev) != hipSuccess) { grid = -1; return; }
        if (hipFuncSetAttribute((const void*)hyb_fwd, hipFuncAttributeMaxDynamicSharedMemorySize, LDS_BYTES) != hipSuccess) { fprintf(stderr, "kernel_launch: hipFuncSetAttribute failed\n"); grid = -1; return; }
        if (hipOccupancyMaxActiveBlocksPerMultiprocessor(&per_cu, (const void*)hyb_fwd, 512, LDS_BYTES) != hipSuccess || per_cu < 1) { fprintf(stderr, "kernel_launch: occupancy query says %d\n", per_cu); per_cu = 1; }
        (void)hipGetLastError();
        grid = cus;
    }
    if (grid < 0) return;
    (void)hipMemsetAsync((char*)d_ws + WS_CTL, 0, CTL_ZERO_BYTES, stream);
    Args a{};
    for (int i = 0; i < 32; ++i) a.in[i] = (const float*)d_in[i];
    a.out = (float*)d_out; a.ws = (unsigned char*)d_ws;
    if (MK_N_LAUNCHES == 1) { a.ph_lo = 0; a.ph_hi = NPHASE; a.li = 0; hipLaunchKernelGGL(hyb_fwd, dim3(grid), dim3(512), LDS_BYTES, stream, a); }
    else for (int p = 0; p < NPHASE; ++p) { a.ph_lo = p; a.ph_hi = p + 1; a.li = p; hipLaunchKernelGGL(hyb_fwd, dim3(grid), dim3(512), LDS_BYTES, stream, a); }
}
```
